# Optimizing an MI355X kernel written in HIP

```python
import jax, jax.numpy as jnp
from jax import lax
import numpy as np

D_MODEL = 4096
BATCH = 4
SEQ = 2048
DEPTH = 4

MEM_LEN = 256
HEAD_DIM = 128
ROPE_THETA = 10000.0
EPS = 1e-6
NEG = -1e30

SC_WIDTH = D_MODEL // 2
SC_KERNEL = 3

NSA_HEADS = 16
NSA_KV_GROUPS = 4
NSA_WIDTH = NSA_HEADS * HEAD_DIM
NSA_BRANCHES = 3
CMP_BLOCK = 32
CMP_STRIDE = 16
SLC_BLOCK = 64
SLC_TOP_N = 16
SLC_Q_BLOCK = 64
WINDOW = 512
Q_BLOCK = 128

X_HEADS = 4
X_WIDTH = X_HEADS * HEAD_DIM

N_BRANCHES = 3
IN_SPLITS = (SC_WIDTH, SC_WIDTH, SC_WIDTH, SC_WIDTH,
             NSA_WIDTH,
             NSA_BRANCHES * 2 * NSA_KV_GROUPS * HEAD_DIM,
             NSA_BRANCHES * NSA_HEADS,
             NSA_WIDTH,
             X_WIDTH, X_WIDTH,
             N_BRANCHES * D_MODEL)
IN_WIDTH = sum(IN_SPLITS)

kernel_name = 'hybrid_conv_nsa_mem_gated_merge'


def rmsnorm(x, g):
    xf = x.astype(jnp.float32)
    y = xf * lax.rsqrt(jnp.mean(xf * xf, axis=-1, keepdims=True) + EPS)
    return (y * g.astype(jnp.float32)).astype(x.dtype)


def rope(x, pos):
    half = HEAD_DIM // 2
    inv_freq = ROPE_THETA ** (-jnp.arange(half, dtype=jnp.float32) / half)
    ang = pos.astype(jnp.float32)[:, None] * inv_freq[None, :]
    cos = jnp.cos(ang)[None, :, None, :]
    sin = jnp.sin(ang)[None, :, None, :]
    xf = x.astype(jnp.float32)
    x1, x2 = xf[..., :half], xf[..., half:]
    return jnp.concatenate([x1 * cos - x2 * sin, x2 * cos + x1 * sin], axis=-1).astype(x.dtype)


def masked_softmax(s, mask):
    p = jax.nn.softmax(jnp.where(mask, s, NEG), axis=-1)
    return jnp.where(mask, p, 0.0)


def short_conv_mixer(a_h, a_b, a_c, conv_w, conv_b):
    seq = a_h.shape[1]
    u = a_c * a_h
    up = jnp.pad(u, ((0, 0), (SC_KERNEL - 1, 0), (0, 0)))
    y = conv_b
    for k in range(SC_KERNEL):
        y = y + conv_w[k] * up[:, k:k + seq]
    return a_b * y


def nsa_mixer(q, kv, gate_logits, cmp_pos, cmp_w1, cmp_w2):
    bsz, seq = q.shape[0], q.shape[1]
    G, R, Dh = NSA_KV_GROUPS, NSA_HEADS // NSA_KV_GROUPS, HEAD_DIM
    scale = Dh ** -0.5
    pos = jnp.arange(seq, dtype=jnp.int32)
    kv = kv.reshape(bsz, seq, NSA_BRANCHES, 2, G, Dh)
    qg = q.reshape(bsz, seq, G, R, Dh)
    qg_rot = rope(q, pos).reshape(bsz, seq, G, R, Dh)

    n_cmp = (seq - CMP_BLOCK) // CMP_STRIDE + 1
    cmp_start = jnp.arange(n_cmp, dtype=jnp.int32) * CMP_STRIDE
    tok = cmp_start[:, None] + jnp.arange(CMP_BLOCK, dtype=jnp.int32)[None, :]
    blk = kv[:, :, 0][:, tok]
    blk = blk + jnp.transpose(cmp_pos, (1, 0, 2))[:, :, None, :]
    blk = jnp.transpose(blk, (0, 1, 3, 4, 2, 5)).reshape(bsz, n_cmp, 2, G, CMP_BLOCK * Dh)
    hid = jax.nn.silu(jnp.einsum('bncgf,cfd->bncgd', blk, cmp_w1))
    kvc = jnp.einsum('bncgd,cde->bncge', hid, cmp_w2)
    k_cmp, v_cmp = kvc[:, :, 0], kvc[:, :, 1]
    s_cmp = jnp.einsum('bsgrd,bngd->bgrsn', qg, k_cmp).astype(jnp.float32) * scale
    cmp_mask = (cmp_start + CMP_BLOCK - 1)[None, :] <= pos[:, None]
    p_cmp = masked_softmax(s_cmp, cmp_mask)
    o_cmp = jnp.einsum('bgrsn,bngd->bsgrd', p_cmp.astype(v_cmp.dtype), v_cmp)

    n_slc = seq // SLC_BLOCK
    slc_start = jnp.arange(n_slc, dtype=jnp.int32) * SLC_BLOCK
    overlap = ((cmp_start[:, None] < slc_start[None, :] + SLC_BLOCK)
               & (cmp_start[:, None] + CMP_BLOCK > slc_start[None, :])).astype(jnp.float32)
    imp = jnp.einsum('bgrsn,nj->bgsj', p_cmp, overlap)
    blk_id = jnp.arange(n_slc, dtype=jnp.int32)[None, :]
    cur = (pos // SLC_BLOCK)[:, None]
    future = slc_start[None, :] > pos[:, None]
    forced = (blk_id == 0) | (blk_id == cur) | (blk_id == cur - 1)
    imp = jnp.where(future, -jnp.inf, jnp.where(forced, jnp.inf, imp))
    n_top = min(SLC_TOP_N, n_slc)
    _, sel = lax.top_k(imp, n_top)

    k_slc = rope(kv[:, :, 1, 0], pos)
    v_slc = kv[:, :, 1, 1]
    ks = k_slc.reshape(bsz, n_slc, SLC_BLOCK, G, Dh).transpose(0, 3, 1, 2, 4)
    vs = v_slc.reshape(bsz, n_slc, SLC_BLOCK, G, Dh).transpose(0, 3, 1, 2, 4)
    nq = seq // SLC_Q_BLOCK
    q_chunks = qg_rot.reshape(bsz, nq, SLC_Q_BLOCK, G, R, Dh).transpose(1, 0, 2, 3, 4, 5)
    sel_chunks = sel.reshape(bsz, G, nq, SLC_Q_BLOCK, n_top).transpose(2, 0, 1, 3, 4)
    pos_chunks = pos.reshape(nq, SLC_Q_BLOCK)
    bi = jnp.arange(bsz)[:, None, None, None]
    gi = jnp.arange(G)[None, :, None, None]
    n_keys = n_top * SLC_BLOCK

    def slc_block(args):
        qc, selc, tc = args
        kc = ks[bi, gi, selc].reshape(bsz, G, SLC_Q_BLOCK, n_keys, Dh)
        vc = vs[bi, gi, selc].reshape(bsz, G, SLC_Q_BLOCK, n_keys, Dh)
        key_pos = (selc[..., None] * SLC_BLOCK + jnp.arange(SLC_BLOCK, dtype=jnp.int32)).reshape(
            bsz, G, SLC_Q_BLOCK, n_keys)
        mask = (key_pos <= tc[None, None, :, None])[:, :, None]
        s = jnp.einsum('bqgrd,bgqmd->bgrqm', qc, kc).astype(jnp.float32) * scale
        p = masked_softmax(s, mask)
        return jnp.einsum('bgrqm,bgqmd->bqgrd', p.astype(vc.dtype), vc)

    o_slc = lax.map(slc_block, (q_chunks, sel_chunks, pos_chunks))
    o_slc = o_slc.transpose(1, 0, 2, 3, 4, 5).reshape(bsz, seq, G, R, Dh)

    k_win = rope(kv[:, :, 2, 0], pos)
    v_win = kv[:, :, 2, 1]
    kp = jnp.pad(k_win, ((0, 0), (WINDOW, 0), (0, 0), (0, 0)))
    vp = jnp.pad(v_win, ((0, 0), (WINDOW, 0), (0, 0), (0, 0)))
    nw = seq // Q_BLOCK
    span = WINDOW + Q_BLOCK
    qw = qg_rot.reshape(bsz, nw, Q_BLOCK, G, R, Dh).transpose(1, 0, 2, 3, 4, 5)
    starts = jnp.arange(nw, dtype=jnp.int32) * Q_BLOCK

    def win_block(args):
        qc, c0 = args
        kc = lax.dynamic_slice_in_dim(kp, c0, span, axis=1)
        vc = lax.dynamic_slice_in_dim(vp, c0, span, axis=1)
        q_pos = c0 + jnp.arange(Q_BLOCK, dtype=jnp.int32)
        k_pos = c0 - WINDOW + jnp.arange(span, dtype=jnp.int32)
        d = q_pos[:, None] - k_pos[None, :]
        mask = (d >= 0) & (d < WINDOW) & (k_pos[None, :] >= 0)
        s = jnp.einsum('bqgrd,bkgd->bgrqk', qc, kc).astype(jnp.float32) * scale
        p = masked_softmax(s, mask)
        return jnp.einsum('bgrqk,bkgd->bqgrd', p.astype(vc.dtype), vc)

    o_win = lax.map(win_block, (qw, starts))
    o_win = o_win.transpose(1, 0, 2, 3, 4, 5).reshape(bsz, seq, G, R, Dh)

    g = jax.nn.sigmoid(gate_logits.astype(jnp.float32)).astype(q.dtype).reshape(
        bsz, seq, NSA_HEADS, NSA_BRANCHES, 1)
    o = (g[:, :, :, 0] * o_cmp.reshape(bsz, seq, NSA_HEADS, Dh)
         + g[:, :, :, 1] * o_slc.reshape(bsz, seq, NSA_HEADS, Dh)
         + g[:, :, :, 2] * o_win.reshape(bsz, seq, NSA_HEADS, Dh))
    return o.reshape(bsz, seq, NSA_WIDTH)


def memory_attention(q, mem_kv):
    k, v = mem_kv[:, :, 0], mem_kv[:, :, 1]
    s = jnp.einsum('bshd,bmhd->bhsm', q, k).astype(jnp.float32) * (HEAD_DIM ** -0.5)
    p = jax.nn.softmax(s, axis=-1)
    return jnp.einsum('bhsm,bmhd->bshd', p.astype(v.dtype), v)


def hybrid_layer(x, mem, norm_g, w_in, conv_w, conv_b, cmp_pos, cmp_w1, cmp_w2,
                 mem_norm_g, w_mem_kv, w_up_a, w_up_b, w_up_x, w_out):
    bsz, seq, _ = x.shape
    h = rmsnorm(x, norm_g)
    proj = h @ w_in
    offs = []
    acc = 0
    for sz in IN_SPLITS[:-1]:
        acc += sz
        offs.append(acc)
    (a_h, a_b, a_c, a_z, n_q, n_kv, n_g, n_z, x_q, x_z, m_g) = jnp.split(proj, offs, axis=-1)

    y_a = short_conv_mixer(a_h, a_b, a_c, conv_w, conv_b) * jax.nn.silu(a_z)

    y_b = nsa_mixer(n_q.reshape(bsz, seq, NSA_HEADS, HEAD_DIM), n_kv, n_g,
                    cmp_pos, cmp_w1, cmp_w2) * jax.nn.silu(n_z)

    mem_kv = (rmsnorm(mem, mem_norm_g) @ w_mem_kv).reshape(bsz, mem.shape[1], 2, X_HEADS, HEAD_DIM)
    y_x = memory_attention(x_q.reshape(bsz, seq, X_HEADS, HEAD_DIM), mem_kv).reshape(
        bsz, seq, X_WIDTH) * jax.nn.silu(x_z)

    gates = jax.nn.sigmoid(m_g.astype(jnp.float32)).astype(x.dtype).reshape(bsz, seq, N_BRANCHES, D_MODEL)
    u = (gates[:, :, 0] * (y_a @ w_up_a)
         + gates[:, :, 1] * (y_b @ w_up_b)
         + gates[:, :, 2] * (y_x @ w_up_x))
    return x + u @ w_out


def setup_inputs(seed: int = 0) -> dict:
    key = jax.random.key(seed)
    ks = jax.random.split(key, 16)
    f32 = jnp.float32
    nrm = lambda k, shape, sc: jax.random.normal(k, shape, f32) * sc
    return {
        'x': nrm(ks[0], (BATCH, SEQ, D_MODEL), 1.0),
        'mem': nrm(ks[1], (BATCH, MEM_LEN, D_MODEL), 1.0),
        'norm_g': 1.0 + nrm(ks[2], (DEPTH, D_MODEL), 0.02),
        'w_in': nrm(ks[3], (DEPTH, D_MODEL, IN_WIDTH), D_MODEL ** -0.5),
        'conv_w': nrm(ks[4], (DEPTH, SC_KERNEL, SC_WIDTH), SC_KERNEL ** -0.5),
        'conv_b': nrm(ks[5], (DEPTH, SC_WIDTH), 0.02),
        'cmp_pos': nrm(ks[6], (DEPTH, 2, CMP_BLOCK, HEAD_DIM), 0.1),
        'cmp_w1': nrm(ks[7], (DEPTH, 2, CMP_BLOCK * HEAD_DIM, HEAD_DIM), (CMP_BLOCK * HEAD_DIM) ** -0.5),
        'cmp_w2': nrm(ks[8], (DEPTH, 2, HEAD_DIM, HEAD_DIM), HEAD_DIM ** -0.5),
        'mem_norm_g': 1.0 + nrm(ks[9], (DEPTH, D_MODEL), 0.02),
        'w_mem_kv': nrm(ks[10], (DEPTH, D_MODEL, 2 * X_WIDTH), D_MODEL ** -0.5),
        'w_up_a': nrm(ks[11], (DEPTH, SC_WIDTH, D_MODEL), SC_WIDTH ** -0.5),
        'w_up_b': nrm(ks[12], (DEPTH, NSA_WIDTH, D_MODEL), NSA_WIDTH ** -0.5),
        'w_up_x': nrm(ks[13], (DEPTH, X_WIDTH, D_MODEL), X_WIDTH ** -0.5),
        'w_out': nrm(ks[14], (DEPTH, D_MODEL, D_MODEL), D_MODEL ** -0.5),
        'final_g': 1.0 + nrm(ks[15], (D_MODEL,), 0.02),
    }


def reference(x, mem, norm_g, w_in, conv_w, conv_b, cmp_pos, cmp_w1, cmp_w2,
              mem_norm_g, w_mem_kv, w_up_a, w_up_b, w_up_x, w_out, final_g):
    for l in range(DEPTH):
        x = hybrid_layer(x, mem, norm_g[l], w_in[l], conv_w[l], conv_b[l], cmp_pos[l],
                         cmp_w1[l], cmp_w2[l], mem_norm_g[l], w_mem_kv[l],
                         w_up_a[l], w_up_b[l], w_up_x[l], w_out[l])
    return rmsnorm(x, final_g)
```

```cpp
#include <hip/hip_runtime.h>
#include <cstdio>
#include <cstdint>
#include <cmath>
namespace pg8 {
#define PG8_LAS __attribute__((address_space(3)))
typedef unsigned short bf16_t;
typedef short bf16x8 __attribute__((ext_vector_type(8)));
typedef float f32x4 __attribute__((ext_vector_type(4)));
typedef unsigned u32x4 __attribute__((ext_vector_type(4)));
constexpr int BM = 256, BK = 64, HALF = 128, HTB = HALF * BK * 2  , STAGE_BYTES = 8 * HTB, NXCD = 8, WGM = 8;

__host__ __device__ __forceinline__ int lds_byte(int r, int c) { const int st = (r >> 4) * 2 + (c >> 5), rr = r & 15, cc = c & 31, ob = rr * 64 + cc * 2; return st * 1024 + (ob ^ (((ob >> 9) & 1) << 5)); }
__host__ __device__ __forceinline__ void stage_rc(int b, int& R, int& C) { const int st = b / 1024, sb = b % 1024, swz = sb ^ (((sb >> 9) & 1) << 5); R = (st >> 1) * 16 + swz / 64; C = (st & 1) * 32 + (swz % 64) / 2; }
__host__ __device__ __forceinline__ int perm32(int rho) { const int n = rho >> 4, i = rho & 15; return 8 * (i >> 2) + 4 * n + (i & 3); }

struct Unit { int pm, pn; };
struct Gemm { const bf16_t* A; const bf16_t* Bt; int M, N, K; };

struct StaticOrder {
    int nM, nN, nwg, G, c;
    __host__ __device__ void init(int M, int N, int G_, int c_) { nM = M / BM; nN = N / BM; nwg = nM * nN; G = G_; c = c_; }
    __host__ __device__ bool next(int i, Unit& u) const {
        const long L = (long)i * G + c; if (L >= nwg) return false;
        int wgid = (int)L; { const int q = nwg / NXCD, r = nwg % NXCD, xcd = wgid % NXCD, off = wgid / NXCD; wgid = (xcd < r ? xcd * (q + 1) : r * (q + 1) + (xcd - r) * q) + off; }
        const int nig = WGM * nN, gid = wgid / nig, fm = gid * WGM, gsz = (nM - fm) < WGM ? (nM - fm) : WGM;
        u.pm = fm + ((wgid % nig) % gsz); u.pn = (wgid % nig) / gsz; return true;
    }
    __device__ __forceinline__ void a_ready(const Unit&) const {}
    __device__ __forceinline__ void done(const Unit&) const {}
};
typedef __bf16 bf16x2v __attribute__((ext_vector_type(2)));
typedef float f32x2v __attribute__((ext_vector_type(2)));
typedef unsigned u32x2 __attribute__((ext_vector_type(2)));
__device__ __forceinline__ unsigned cvt_pk_bf16(float lo, float hi) { f32x2v v = {lo, hi}; bf16x2v b = __builtin_convertvector(v, bf16x2v); return __builtin_bit_cast(unsigned, b); }
__device__ __forceinline__ float bflo(unsigned w) { return __uint_as_float(w << 16); }
__device__ __forceinline__ float bfhi(unsigned w) { return __uint_as_float(w & 0xffff0000u); }
__device__ __forceinline__ float sigmoidf_(float x) { return __builtin_amdgcn_rcpf(1.0f + __builtin_amdgcn_exp2f(-1.4426950408889634f * x)); }
__device__ __forceinline__ u32x4 pack8(const f32x4& v0, const f32x4& v1) { u32x4 w; w.x = cvt_pk_bf16(v0[0], v0[1]); w.y = cvt_pk_bf16(v0[2], v0[3]); w.z = cvt_pk_bf16(v1[0], v1[1]); w.w = cvt_pk_bf16(v1[2], v1[3]); return w; }

__device__ __forceinline__ unsigned q8_(float g) { return (unsigned)__builtin_fminf(g * 256.0f, 255.0f); }
__device__ __forceinline__ f32x2v gq2_(float a, float b) {
    const f32x2v x = {__builtin_amdgcn_fmed3f(a, -6.5f, 6.5f), __builtin_amdgcn_fmed3f(b, -6.5f, 6.5f)}; const f32x2v x2 = x * x;
    f32x2v p = x2 * (256.0f * 1.693533924e-10f) + (256.0f * -2.709654433e-08f);
    p = p * x2 + (256.0f * 1.777740446e-06f); p = p * x2 + (256.0f * -6.258466407e-05f); p = p * x2 + (256.0f * 1.324479733e-03f);
    p = p * x2 + (256.0f * -1.883604263e-02f); p = p * x2 + (256.0f * 2.483712057e-01f);
    const f32x2v y = p * x + 127.5f; return y + 12582912.0f;
}
__device__ __forceinline__ unsigned gpk4_(const f32x4& v) { const f32x2v a = gq2_(v[0], v[1]), b = gq2_(v[2], v[3]);
    return __builtin_amdgcn_perm(__float_as_uint(a.y), __float_as_uint(a.x), 0x0c0c0400u) | (__builtin_amdgcn_perm(__float_as_uint(b.y), __float_as_uint(b.x), 0x0c0c0400u) << 16); }
struct EpiProj {
    static constexpr bool PERM = true, AFTER_DRAIN = false, HAS_MID = false; static constexpr int MID0 = -1, MID1 = -1;
    bf16_t* O; int ldc; const float* rstd_g;
    PG8_LAS const float* rt;
    unsigned char* G8; int ldg, gate_pn0;
    __device__ __forceinline__ float row_scale(const Unit&, int row, int rloc) const { return rstd_g ? rstd_g[row] : rt[rloc]; }
    __device__ __forceinline__ void operator()(const f32x4 (&acc)[2][2][4][2], const Unit& u, int wr, int wc, int fr, int fq) const {
        const int rl0 = wr * 64 + fr, row0 = u.pm * BM + rl0;
        if (u.pn < gate_pn0) {
            const int col0 = u.pn * BM + wc * 32 + 8 * fq;
#pragma unroll
            for (int ai = 0; ai < 2; ++ai)
#pragma unroll
                for (int m = 0; m < 4; ++m) { const int row = row0 + ai * HALF + m * 16; const float rs = row_scale(u, row, rl0 + ai * HALF + m * 16); bf16_t* rowp = O + (size_t)row * ldc + col0;
#pragma unroll
                    for (int bj = 0; bj < 2; ++bj) { const f32x4 v0 = acc[ai][bj][m][0] * rs, v1 = acc[ai][bj][m][1] * rs; *(u32x4*)(rowp + bj * HALF) = pack8(v0, v1); } }
        } else {
            const int col0 = (u.pn - gate_pn0) * BM + wc * 32 + 8 * fq;
#pragma unroll
            for (int ai = 0; ai < 2; ++ai)
#pragma unroll
                for (int m = 0; m < 4; ++m) { const int row = row0 + ai * HALF + m * 16; const float rs = row_scale(u, row, rl0 + ai * HALF + m * 16); unsigned char* rowp = G8 + (size_t)row * ldg + col0;
#pragma unroll
                    for (int bj = 0; bj < 2; ++bj) { const f32x4 v0 = acc[ai][bj][m][0] * rs, v1 = acc[ai][bj][m][1] * rs; u32x2 w;
                        w.x = gpk4_(v0); w.y = gpk4_(v1);
                        *(u32x2*)(rowp + bj * HALF) = w; } }
        }
    }
};
__device__ __forceinline__ int perm16(int k) { return 8 * ((k >> 2) & 1) + 4 * (k >> 3) + (k & 3); }
__device__ __forceinline__ float ub_(unsigned w, int k) { return (float)((w >> (8 * k)) & 0xffu) + 0.5f; }
struct EpiUpF {
    static constexpr bool PERM = true, AFTER_DRAIN = false, HAS_MID = true; static constexpr int MID0 = 32, MID1 = 64;
    const unsigned char* G; int ldg, gstride; bf16_t* UB; int ldu;
    __device__ __forceinline__ void mid(f32x4 (&acc)[2][2][4][2], const Unit& u, bool second, int wr, int wc, int fr, int fq) const {
        const __amdgpu_buffer_rsrc_t rs = __builtin_amdgcn_make_buffer_rsrc((void*)G, 0, 0x7fffffff, 0x00020000);
        const int voff = (u.pm * BM + wr * 64 + fr) * ldg + u.pn * BM + wc * 32 + 8 * fq; const int sbase = second ? gstride : 0;
#pragma unroll
        for (int ai = 0; ai < 2; ++ai) {
            u32x2 ga[4][2], gb[4][2];
#pragma unroll
            for (int m = 0; m < 4; ++m)
#pragma unroll
                for (int bj = 0; bj < 2; ++bj) { const int so = sbase + (ai * HALF + m * 16) * ldg + bj * HALF;
                    ga[m][bj] = __builtin_amdgcn_raw_buffer_load_b64(rs, voff, so, 0); gb[m][bj] = __builtin_amdgcn_raw_buffer_load_b64(rs, voff, so + gstride, 0); }
#pragma unroll
            for (int m = 0; m < 4; ++m)
#pragma unroll
                for (int bj = 0; bj < 2; ++bj) { const u32x2 a = ga[m][bj], b = gb[m][bj];
                    const f32x4 r0 = {ub_(a.x, 0) * __builtin_amdgcn_rcpf(ub_(b.x, 0)), ub_(a.x, 1) * __builtin_amdgcn_rcpf(ub_(b.x, 1)), ub_(a.x, 2) * __builtin_amdgcn_rcpf(ub_(b.x, 2)), ub_(a.x, 3) * __builtin_amdgcn_rcpf(ub_(b.x, 3))};
                    acc[ai][bj][m][0] = acc[ai][bj][m][0] * r0;
                    const f32x4 r1 = {ub_(a.y, 0) * __builtin_amdgcn_rcpf(ub_(b.y, 0)), ub_(a.y, 1) * __builtin_amdgcn_rcpf(ub_(b.y, 1)), ub_(a.y, 2) * __builtin_amdgcn_rcpf(ub_(b.y, 2)), ub_(a.y, 3) * __builtin_amdgcn_rcpf(ub_(b.y, 3))};
                    acc[ai][bj][m][1] = acc[ai][bj][m][1] * r1; }
            asm volatile("" ::: "memory"); }
    }
    __device__ __forceinline__ void operator()(const f32x4 (&acc)[2][2][4][2], const Unit& u, int wr, int wc, int fr, int fq) const {
        const __amdgpu_buffer_rsrc_t rs = __builtin_amdgcn_make_buffer_rsrc((void*)G, 0, 0x7fffffff, 0x00020000);
        const int row0 = u.pm * BM + wr * 64 + fr, col0 = u.pn * BM + wc * 32 + 8 * fq; const int voff = row0 * ldg + col0;
#pragma unroll
        for (int ai = 0; ai < 2; ++ai) {
            u32x2 gwv[4][2];
#pragma unroll
            for (int m = 0; m < 4; ++m)
#pragma unroll
                for (int bj = 0; bj < 2; ++bj) gwv[m][bj] = __builtin_amdgcn_raw_buffer_load_b64(rs, voff, 2 * gstride + (ai * HALF + m * 16) * ldg + bj * HALF, 0);
#pragma unroll
            for (int m = 0; m < 4; ++m) { const int row = row0 + ai * HALF + m * 16;
#pragma unroll
                for (int bj = 0; bj < 2; ++bj) { const int col = col0 + bj * HALF; const u32x2 gw = gwv[m][bj]; const float k = 1.0f / 256.0f;
                    const f32x4 g0 = {ub_(gw.x, 0) * k, ub_(gw.x, 1) * k, ub_(gw.x, 2) * k, ub_(gw.x, 3) * k}, g1 = {ub_(gw.y, 0) * k, ub_(gw.y, 1) * k, ub_(gw.y, 2) * k, ub_(gw.y, 3) * k};
                    *(u32x4*)(UB + (size_t)row * ldu + col) = pack8(acc[ai][bj][m][0] * g0, acc[ai][bj][m][1] * g1); } }
            asm volatile("" ::: "memory"); }
    }
};
struct EpiOut {
    static constexpr bool PERM = true, AFTER_DRAIN = false, HAS_MID = false; static constexpr int MID0 = -1, MID1 = -1;
    bf16_t* xb; float* ssqp; int ldc;
    __device__ __forceinline__ void operator()(const f32x4 (&acc)[2][2][4][2], const Unit& u, int wr, int wc, int fr, int fq) const {
        const int row0 = u.pm * BM + wr * 64 + fr, col0 = u.pn * BM + wc * 32 + 8 * fq;
#pragma unroll
        for (int ai = 0; ai < 2; ++ai)
#pragma unroll
            for (int m = 0; m < 4; ++m) { const int row = row0 + ai * HALF + m * 16; float ss = 0.f;
#pragma unroll
                for (int bj = 0; bj < 2; ++bj) { const size_t off = (size_t)row * ldc + col0 + bj * HALF; const u32x4 xo = *(const u32x4*)(xb + off);
                    const f32x4 v0 = (f32x4){bflo(xo.x), bfhi(xo.x), bflo(xo.y), bfhi(xo.y)} + acc[ai][bj][m][0], v1 = (f32x4){bflo(xo.z), bfhi(xo.z), bflo(xo.w), bfhi(xo.w)} + acc[ai][bj][m][1];
                    *(u32x4*)(xb + off) = pack8(v0, v1);
                    ss += (v0[0] * v0[0] + v0[1] * v0[1]) + (v0[2] * v0[2] + v0[3] * v0[3]) + (v1[0] * v1[0] + v1[1] * v1[1]) + (v1[2] * v1[2] + v1[3] * v1[3]); }
                ss += __shfl_xor(ss, 16); ss += __shfl_xor(ss, 32);
                if (fq == 0) ssqp[(size_t)row * 64 + u.pn * 4 + wc] = ss; }
    }
};

template <class Epi, class Sched, bool ALIGN_EPI = false, bool SP2 = false>
__device__ __forceinline__ void gemm_phase(PG8_LAS unsigned char* lds, const Gemm g, const Sched& S, const Epi& E) {
    int tid = threadIdx.x; asm volatile("" : "+v"(tid)); const int wid = __builtin_amdgcn_readfirstlane(tid >> 6), lane = tid & 63, wr = wid >> 2, wc = wid & 3, fr = lane & 15, fq = lane >> 4;
    const int K = g.K, nt = K / BK;
    unsigned voffA[2], voffB[2];
#pragma unroll
    for (int i = 0; i < 2; ++i) { int R, C; stage_rc(tid * 16 + i * 8192, R, C); const int Rb = Epi::PERM ? ((R & ~31) + perm32(R & 31)) : R;
        voffA[i] = (unsigned)(R * K + C) * 2u; voffB[i] = (unsigned)(Rb * K + C) * 2u; }
    const size_t kstep = (size_t)(BK * 2);
    const size_t hstep = (size_t)HALF * K * 2;
    const size_t tstep = 2 * hstep;
    const unsigned ldsw = (unsigned)wid * 1024u;
    const int aoff = lds_byte(wr * 64 + fr, fq * 8), boff = lds_byte(wc * 32 + fr, fq * 8);
#define PG8_SA(b, h) (((b) * 2 + (h)) * HTB)
#define PG8_SB(b, h) ((4 + (b) * 2 + (h)) * HTB)
#define PG8_STAGE(bufoff, gbase, voff) do { _Pragma("unroll") for (int _i = 0; _i < 2; ++_i) \
        __builtin_amdgcn_global_load_lds((const unsigned*)((const char*)(gbase) + (voff)[_i]), (PG8_LAS unsigned*)(lds + (bufoff) + ldsw + _i * 8192), 16, 0, PG8_AAUX); } while (0)
#ifndef PG8_BAUX
#define PG8_BAUX 0
#endif
#ifndef PG8_AAUX
#define PG8_AAUX 0
#endif
#define PG8_STAGEB(bufoff, gbase, voff) do { _Pragma("unroll") for (int _i = 0; _i < 2; ++_i) \
        __builtin_amdgcn_global_load_lds((const unsigned*)((const char*)(gbase) + (voff)[_i]), (PG8_LAS unsigned*)(lds + (bufoff) + ldsw + _i * 8192), 16, 0, PG8_BAUX); } while (0)
#define PG8_LDA(dst, b, h) do { _Pragma("unroll") for (int m = 0; m < 4; ++m) _Pragma("unroll") for (int k = 0; k < 2; ++k) dst[m][k] = *(const PG8_LAS bf16x8*)(lds + PG8_SA(b, h) + aoff + m * 2048 + k * 1024); } while (0)
#define PG8_LDB(dst, b, h) do { _Pragma("unroll") for (int n = 0; n < 2; ++n) _Pragma("unroll") for (int k = 0; k < 2; ++k) dst[n][k] = *(const PG8_LAS bf16x8*)(lds + PG8_SB(b, h) + boff + n * 2048 + k * 1024); } while (0)
#define PG8_MMA(ai, bj, At, Bt) do { __builtin_amdgcn_s_setprio(1); _Pragma("unroll") for (int m = 0; m < 4; ++m) _Pragma("unroll") for (int n = 0; n < 2; ++n) _Pragma("unroll") for (int k = 0; k < 2; ++k) \
        acc[ai][bj][m][n] = __builtin_amdgcn_mfma_f32_16x16x32_bf16(Bt[n][k], At[m][k], acc[ai][bj][m][n], 0, 0, 0); __builtin_amdgcn_s_setprio(0); } while (0)
#define PG8_WAIT_V(n) asm volatile("s_waitcnt vmcnt(" #n ")" ::: "memory")
#define PG8_WAIT_L(n) asm volatile("s_waitcnt lgkmcnt(" #n ")" ::: "memory")
#define PG8_BAR __builtin_amdgcn_s_barrier()
#define PG8_SCHED __builtin_amdgcn_sched_barrier(0)
    Unit cur, nxt; int ui = 0;
    if (!S.next(0, cur)) return;
    f32x4 acc[2][2][4][2];
#pragma unroll
    for (int a = 0; a < 2; ++a)
#pragma unroll
        for (int b = 0; b < 2; ++b)
#pragma unroll
            for (int m = 0; m < 4; ++m)
#pragma unroll
                for (int n = 0; n < 2; ++n) acc[a][b][m][n] = (f32x4){0.f, 0.f, 0.f, 0.f};
    bf16x8 At[4][2], B0[2][2], B1[2][2];
    const char* cA = (const char*)g.A + (size_t)cur.pm * tstep; const char* cB = (const char*)g.Bt + (size_t)cur.pn * tstep;
    S.a_ready(cur);
    if constexpr (SP2) {
        PG8_STAGEB(PG8_SB(0, 0), cB, voffB); PG8_STAGEB(PG8_SB(0, 1), cB + hstep, voffB); PG8_STAGE(PG8_SA(0, 0), cA, voffA); PG8_STAGE(PG8_SA(0, 1), cA + hstep, voffA);
        if (wr == 1) PG8_BAR;
        PG8_WAIT_V(2); PG8_BAR;
        PG8_STAGEB(PG8_SB(1, 0), cB + kstep, voffB); PG8_STAGE(PG8_SA(1, 0), cA + kstep, voffA); PG8_STAGEB(PG8_SB(1, 1), cB + hstep + kstep, voffB);
        PG8_WAIT_V(6); PG8_BAR;
    } else {
        PG8_STAGEB(PG8_SB(0, 0), cB, voffB); PG8_STAGE(PG8_SA(0, 0), cA, voffA); PG8_STAGEB(PG8_SB(0, 1), cB + hstep, voffB); PG8_STAGE(PG8_SA(0, 1), cA + hstep, voffA);
        if (wr == 1) PG8_BAR;
        PG8_WAIT_V(4); PG8_BAR;
        PG8_STAGEB(PG8_SB(1, 0), cB + kstep, voffB); PG8_STAGE(PG8_SA(1, 0), cA + kstep, voffA); PG8_STAGEB(PG8_SB(1, 1), cB + hstep + kstep, voffB);
        PG8_WAIT_V(6); PG8_BAR;
    }
    for (;;) {
        const bool has_next = S.next(ui + 1, nxt);
        const char* nA = has_next ? (const char*)g.A + (size_t)nxt.pm * tstep : cA; const char* nB = has_next ? (const char*)g.Bt + (size_t)nxt.pn * tstep : cB;
        for (int t = 0; t < nt; t += 2) {
            const bool last = (t == nt - 2);
            const char* a1 = cA + (size_t)(t + 1) * kstep;
            const char* a2 = last ? nA : cA + (size_t)(t + 2) * kstep; const char* b2 = last ? nB : cB + (size_t)(t + 2) * kstep;
            const char* a3 = a2 + kstep; const char* b3 = b2 + kstep;
            if (last && has_next) S.a_ready(nxt);
            if constexpr (Epi::HAS_MID) { if (t == Epi::MID0 || t == Epi::MID1) E.mid(acc, cur, t == Epi::MID1, wr, wc, fr, fq); }
            if constexpr (SP2) {
            PG8_LDB(B0, 0, 0); PG8_LDB(B1, 0, 1); PG8_SCHED; PG8_LDA(At, 0, 0); PG8_STAGE(PG8_SA(1, 1), a1 + hstep, voffA);
            PG8_WAIT_V(8); PG8_WAIT_L(0); PG8_BAR; PG8_MMA(0, 0, At, B0); PG8_MMA(0, 1, At, B1); PG8_BAR; PG8_SCHED;
            PG8_LDA(At, 0, 1); PG8_STAGEB(PG8_SB(0, 0), b2, voffB); PG8_STAGEB(PG8_SB(0, 1), b2 + hstep, voffB); PG8_STAGE(PG8_SA(0, 0), a2, voffA);
            PG8_WAIT_V(8); PG8_WAIT_L(0); PG8_BAR; PG8_MMA(1, 0, At, B0); PG8_MMA(1, 1, At, B1); PG8_BAR; PG8_SCHED;
            PG8_LDB(B0, 1, 0); PG8_LDB(B1, 1, 1); PG8_SCHED; PG8_LDA(At, 1, 0); PG8_STAGE(PG8_SA(0, 1), a2 + hstep, voffA);
            PG8_WAIT_V(8); PG8_WAIT_L(0); PG8_BAR; PG8_MMA(0, 0, At, B0); PG8_MMA(0, 1, At, B1); PG8_BAR; PG8_SCHED;
            PG8_LDA(At, 1, 1); PG8_STAGEB(PG8_SB(1, 0), b3, voffB); PG8_STAGEB(PG8_SB(1, 1), b3 + hstep, voffB); PG8_STAGE(PG8_SA(1, 0), a3, voffA);
            PG8_WAIT_V(8); PG8_WAIT_L(0); PG8_BAR; PG8_MMA(1, 0, At, B0); PG8_MMA(1, 1, At, B1); PG8_BAR; PG8_SCHED;
            } else {
            PG8_LDB(B0, 0, 0); PG8_SCHED; PG8_LDA(At, 0, 0); PG8_STAGE(PG8_SA(1, 1), a1 + hstep, voffA);
            PG8_WAIT_L(8); PG8_BAR; PG8_WAIT_L(0); PG8_MMA(0, 0, At, B0); PG8_BAR; PG8_SCHED;
            PG8_LDB(B1, 0, 1); PG8_STAGEB(PG8_SB(0, 0), b2, voffB);
            PG8_BAR; PG8_WAIT_L(0); PG8_MMA(0, 1, At, B1); PG8_BAR;
            PG8_LDA(At, 0, 1); PG8_STAGE(PG8_SA(0, 0), a2, voffA);
            PG8_BAR; PG8_WAIT_L(0); PG8_MMA(1, 0, At, B0); PG8_BAR; PG8_SCHED;
            PG8_STAGEB(PG8_SB(0, 1), b2 + hstep, voffB);
            PG8_WAIT_V(6); PG8_BAR; PG8_MMA(1, 1, At, B1); PG8_BAR;
            PG8_LDB(B0, 1, 0); PG8_SCHED; PG8_LDA(At, 1, 0); PG8_STAGE(PG8_SA(0, 1), a2 + hstep, voffA);
            PG8_WAIT_L(8); PG8_BAR; PG8_WAIT_L(0); PG8_MMA(0, 0, At, B0); PG8_BAR; PG8_SCHED;
            PG8_LDB(B1, 1, 1); PG8_STAGEB(PG8_SB(1, 0), b3, voffB);
            PG8_BAR; PG8_WAIT_L(0); PG8_MMA(0, 1, At, B1); PG8_BAR;
            PG8_LDA(At, 1, 1); PG8_STAGE(PG8_SA(1, 0), a3, voffA);
            PG8_BAR; PG8_WAIT_L(0); PG8_MMA(1, 0, At, B0); PG8_BAR; PG8_SCHED;
            PG8_STAGEB(PG8_SB(1, 1), b3 + hstep, voffB);
            PG8_WAIT_V(6); PG8_BAR; PG8_MMA(1, 1, At, B1); PG8_BAR;
            }
        }
        if constexpr (ALIGN_EPI) { if (wr == 0) PG8_BAR; }
        if constexpr (!Epi::AFTER_DRAIN) { E(acc, cur, wr, wc, fr, fq); S.done(cur); }
        if (!has_next) break;
#pragma unroll
        for (int a = 0; a < 2; ++a)
#pragma unroll
            for (int b = 0; b < 2; ++b)
#pragma unroll
                for (int m = 0; m < 4; ++m)
#pragma unroll
                    for (int n = 0; n < 2; ++n) acc[a][b][m][n] = (f32x4){0.f, 0.f, 0.f, 0.f};
        cur = nxt; cA = nA; cB = nB; ++ui;
        if constexpr (ALIGN_EPI) { if (wr == 1) PG8_BAR; }
    }
    PG8_WAIT_V(0);
    if constexpr (!ALIGN_EPI) { if (wr == 0) PG8_BAR; }
    PG8_BAR;
    if constexpr (Epi::AFTER_DRAIN) { E.fused(acc, cur, wr, wc, fr, fq, lds, wid, lane); S.done(cur); }
#undef PG8_SA
#undef PG8_SB
#undef PG8_STAGE
#undef PG8_STAGEB
#undef PG8_LDA
#undef PG8_LDB
#undef PG8_MMA
#undef PG8_WAIT_V
#undef PG8_WAIT_L
#undef PG8_BAR
#undef PG8_SCHED
}
}

#define LAS __attribute__((address_space(3)))
typedef unsigned short bf16;
typedef short bf16x8 __attribute__((ext_vector_type(8)));
typedef float f32x4 __attribute__((ext_vector_type(4)));
typedef float f32x16 __attribute__((ext_vector_type(16)));
typedef unsigned u32x4 __attribute__((ext_vector_type(4)));
typedef unsigned u32x2 __attribute__((ext_vector_type(2)));
using pg8::cvt_pk_bf16; using pg8::bflo; using pg8::bfhi; using pg8::sigmoidf_; using pg8::perm16;

constexpr int DM = 4096, NBAT = 4, SEQ = 2048, NLAY = 4, TOK = NBAT * SEQ, HD = 128;
constexpr int NP = 28672;
constexpr int C_AH = 0, C_AB = 2048, C_AC = 4096, C_AZ = 6144, C_NQ = 8192, C_KV = 10240, C_NZ = 13312, C_XQ = 15360, C_XZ = 15872, C_MG = 16384;
constexpr int INW = 28720, S_NG = 13312, S_NZ = 13360;
constexpr float EPS = 1e-6f;
constexpr int NWAVES = 8;

constexpr size_t CTL_BYTES = 1u << 20;
constexpr size_t WS_WIN = CTL_BYTES;
constexpr int YK = 4608;
constexpr size_t WS_WUP = WS_WIN + (size_t)NLAY * NP * DM * 2;
constexpr size_t WS_WO = WS_WUP + (size_t)NLAY * DM * YK * 2;
constexpr size_t WS_WMKV = WS_WO + (size_t)NLAY * DM * DM * 2;
constexpr size_t WS_W1 = WS_WMKV + (size_t)4096 * DM * 2;
constexpr size_t WS_W2 = WS_W1 + (size_t)NLAY * 2 * 128 * 4096 * 2;
constexpr size_t WS_PB = WS_W2 + (size_t)NLAY * 2 * 128 * 128 * 2;
constexpr size_t WS_COS = WS_PB + 4096;
constexpr size_t WS_SIN = WS_COS + (size_t)SEQ * 64 * 4;
constexpr size_t WS_XB = WS_SIN + (size_t)SEQ * 64 * 4;
constexpr size_t WS_MEMB = WS_XB + (size_t)TOK * DM * 2;
constexpr size_t WS_RSTDM = WS_MEMB + (size_t)1024 * DM * 2;
constexpr size_t WS_SSQP = WS_RSTDM + 4096;
constexpr size_t WS_RSTD = WS_SSQP + (size_t)TOK * 64 * 4;
constexpr size_t WS_P = WS_RSTD + (size_t)TOK * 4;
constexpr size_t WS_MEMK = WS_P + (size_t)TOK * NP * 2;
constexpr size_t WS_MEMVT = WS_MEMK + (size_t)1024 * 4096 * 2;
constexpr size_t WS_KR = WS_MEMVT + (size_t)NLAY * 16 * 256 * 128 * 2;
constexpr size_t WS_VT = WS_KR + (size_t)2 * 16 * SEQ * 128 * 2;
constexpr size_t WS_KC = WS_VT + (size_t)2 * 16 * SEQ * 128 * 2;
constexpr size_t WS_VTC = WS_KC + (size_t)16 * 128 * 128 * 2;
constexpr size_t WS_Y = WS_VTC + (size_t)16 * 128 * 128 * 2;
constexpr size_t WS_UB = WS_Y + (size_t)TOK * YK * 2;
constexpr size_t WS_MEMK2 = WS_UB + (size_t)TOK * DM * 2;
constexpr size_t WS_WG = WS_MEMK2 + (size_t)NLAY * 16 * 256 * 128 * 2;
constexpr size_t WS_NG = WS_WG + (size_t)NLAY * 64 * DM * 2;
constexpr size_t WS_TSC = WS_NG + (size_t)TOK * 48 * 4;
constexpr size_t WS_G8 = WS_TSC + (size_t)320 * 8 * 32 * 64 * 4;
constexpr size_t WS_END = WS_G8 + (size_t)TOK * 3 * DM;
constexpr int CW_Q = 12288;
constexpr int CW_BAR = 4096;

constexpr int RING_BYTES = 131072, MISC_OFF = RING_BYTES + 320, RT_OFF = RING_BYTES + 2048  , LDS_BYTES = 147456;
constexpr int A_KB0 = 0, A_KB1 = 16384, A_VB0 = 32768, A_VB1 = 49152, A_IMPW = 65536;
constexpr int A_IMPS = A_IMPW + 8 * 32 * 33 * 4, A_SELM = A_IMPS + 64 * 33 * 4, A_END = A_SELM + 256;
static_assert(A_END <= RING_BYTES, "attention LDS map");

#define LDS_WAIT() asm volatile("s_waitcnt lgkmcnt(0)" ::: "memory")
__device__ __forceinline__ int bx_now() { int b = blockIdx.x; asm volatile("" : "+s"(b)); return b; }
__device__ __forceinline__ int tid_now() { int t = threadIdx.x; asm volatile("" : "+v"(t)); return t; }
__device__ __forceinline__ float bf2f(bf16 v) { return __uint_as_float(((unsigned)v) << 16); }
__device__ __forceinline__ bf16 f2bf(float f) { return (bf16)(cvt_pk_bf16(f, 0.f) & 0xffffu); }
__device__ __forceinline__ float wave_sum(float v) {
#pragma unroll
    for (int o = 1; o < 64; o <<= 1) v += __shfl_xor(v, o);
    return v;
}
__device__ __forceinline__ float siluf_(float x) { return x * sigmoidf_(x); }

#define XB_TMO      128
#define XB_XCNT(j)  (256  + 64 * (j))
#define XB_XSUB(j)  (1280 + 64 * (j))
#define XB_XGEN(j)  (2304 + 64 * (j))
#define XB_TOP      3328
#define XB_TOPGEN   3392
#define XCD_BAR_WORDS 3456
#define XB_SPIN_CAP (1u << 22)
__device__ __forceinline__ unsigned xb_ld(unsigned* p)              { return __hip_atomic_load(p, __ATOMIC_RELAXED, __HIP_MEMORY_SCOPE_AGENT); }
__device__ __forceinline__ unsigned xb_add(unsigned* p, unsigned v) { return __hip_atomic_fetch_add(p, v, __ATOMIC_RELAXED, __HIP_MEMORY_SCOPE_AGENT); }
__device__ __forceinline__ unsigned xb_xcc_id() { return (unsigned)__builtin_amdgcn_s_getreg((3 << 11) | 20) & 0xFu; }
#define XB_SPIN(cond, bar) do { unsigned _sp = 0; while (cond) { __builtin_amdgcn_s_sleep(1); \
    if ((++_sp & 255u) == 0u) { if (xb_ld(&(bar)[XB_TMO])) break; if (_sp > XB_SPIN_CAP) { atomicAdd(&(bar)[XB_TMO], 1u); break; } } } } while (0)
struct XcdBarrier { unsigned* bar; unsigned x; volatile LAS unsigned* st; };
__device__ __forceinline__ XcdBarrier xcd_barrier_post(unsigned* bar, volatile LAS unsigned* st) {
    XcdBarrier b; b.bar = bar; b.x = xb_xcc_id(); b.st = st;
    if (threadIdx.x == 0) (void)xb_add(&bar[XB_XCNT(b.x)], 1u);
    return b;
}
__device__ __forceinline__ void xcd_barrier_complete(unsigned* bar, unsigned x, unsigned& nloc, unsigned& nx) {
    const unsigned G = gridDim.x * gridDim.y * gridDim.z;
    unsigned sum, cnt, mine, sp = 0u;
    for (;;) {
        sum = 0u; cnt = 0u; mine = 0u;
#pragma unroll
        for (unsigned j = 0; j < 16; ++j) { const unsigned c = xb_ld(&bar[XB_XCNT(j)]); sum += c; cnt += (c > 0u) ? 1u : 0u; mine = (j == x) ? c : mine; }
        if (sum == G) break;
        __builtin_amdgcn_s_sleep(1);
        if ((++sp & 255u) == 0u) { if (xb_ld(&bar[XB_TMO])) break; if (sp > XB_SPIN_CAP) { atomicAdd(&bar[XB_TMO], 1u); break; } }
    }
    nloc = mine > 0u ? mine : 1u; nx = cnt > 0u ? cnt : 1u;
}
__device__ __forceinline__ void xcd_barrier(const XcdBarrier& b) {
    asm volatile("s_waitcnt vmcnt(0)" ::: "memory");
    __syncthreads();
    if (threadIdx.x == 0) {
        unsigned* bar = b.bar;
        __builtin_amdgcn_s_waitcnt(0);
        unsigned nloc = b.st[0], nx = b.st[1];
        if (nloc == 0u) { xcd_barrier_complete(bar, b.x, nloc, nx); b.st[0] = nloc; b.st[1] = nx; }
        const unsigned old = xb_add(&bar[XB_XSUB(b.x)], 1u);
        const unsigned gen = old / nloc;
        if (old + 1u == (gen + 1u) * nloc) {
            __builtin_amdgcn_fence(__ATOMIC_RELEASE, "agent");
            asm volatile("s_waitcnt vmcnt(0)" ::: "memory");
            const unsigned og = xb_add(&bar[XB_TOP], 1u);
            const unsigned tg = og / nx;
            if (og + 1u == (tg + 1u) * nx) xb_add(&bar[XB_TOPGEN], 1u);
            else XB_SPIN(xb_ld(&bar[XB_TOPGEN]) == tg, bar);
            __builtin_amdgcn_fence(__ATOMIC_ACQUIRE, "agent");
            xb_add(&bar[XB_XGEN(b.x)], 1u);
            asm volatile("s_waitcnt vmcnt(0)" ::: "memory");
        } else {
            XB_SPIN(xb_ld(&bar[XB_XGEN(b.x)]) == gen, bar);
            __builtin_amdgcn_fence(__ATOMIC_ACQUIRE, "agent");
            asm volatile("s_waitcnt vmcnt(0)" ::: "memory");
        }
    }
    __syncthreads();
}

struct Ctx {
    const float *x, *mem, *norm_g, *w_in, *conv_w, *conv_b, *cmp_pos, *cmp_w1, *cmp_w2, *mem_norm_g, *w_mem_kv, *w_up_a, *w_up_b, *w_up_x, *w_out, *final_g;
    float* out;
    unsigned char* ws;
    int G, vcu;
    __device__ __forceinline__ bf16* Win_t() const { return (bf16*)(ws + WS_WIN); }
    __device__ __forceinline__ bf16* Wup_t() const { return (bf16*)(ws + WS_WUP); }
    __device__ __forceinline__ bf16* Wo_t() const { return (bf16*)(ws + WS_WO); }
    __device__ __forceinline__ bf16* Wmkv_t() const { return (bf16*)(ws + WS_WMKV); }
    __device__ __forceinline__ bf16* W1_t() const { return (bf16*)(ws + WS_W1); }
    __device__ __forceinline__ bf16* W2_t() const { return (bf16*)(ws + WS_W2); }
    __device__ __forceinline__ float* pb() const { return (float*)(ws + WS_PB); }
    __device__ __forceinline__ float* cost() const { return (float*)(ws + WS_COS); }
    __device__ __forceinline__ float* sint() const { return (float*)(ws + WS_SIN); }
    __device__ __forceinline__ float* rstdm() const { return (float*)(ws + WS_RSTDM); }
    __device__ __forceinline__ float* ssqp() const { return (float*)(ws + WS_SSQP); }
    __device__ __forceinline__ float* rstd() const { return (float*)(ws + WS_RSTD); }
    __device__ __forceinline__ bf16* xb() const { return (bf16*)(ws + WS_XB); }
    __device__ __forceinline__ bf16* memb() const { return (bf16*)(ws + WS_MEMB); }
    __device__ __forceinline__ bf16* P() const { return (bf16*)(ws + WS_P); }
    __device__ __forceinline__ bf16* MKV() const { return (bf16*)(ws + WS_MEMK); }
    __device__ __forceinline__ bf16* memK() const { return (bf16*)(ws + WS_MEMK2); }
    __device__ __forceinline__ bf16* memVt() const { return (bf16*)(ws + WS_MEMVT); }
    __device__ __forceinline__ bf16* Kr() const { return (bf16*)(ws + WS_KR); }
    __device__ __forceinline__ bf16* Vt() const { return (bf16*)(ws + WS_VT); }
    __device__ __forceinline__ bf16* Kc() const { return (bf16*)(ws + WS_KC); }
    __device__ __forceinline__ bf16* Vtc() const { return (bf16*)(ws + WS_VTC); }
    __device__ __forceinline__ bf16* Y() const { return (bf16*)(ws + WS_Y); }
    __device__ __forceinline__ bf16* UB() const { return (bf16*)(ws + WS_UB); }
    __device__ __forceinline__ unsigned* tsc() const { return (unsigned*)(ws + WS_TSC); }
    __device__ __forceinline__ bf16* Wg_t() const { return (bf16*)(ws + WS_WG); }
    __device__ __forceinline__ float* ng() const { return (float*)(ws + WS_NG); }
    __device__ __forceinline__ unsigned char* G8() const { return ws + WS_G8; }
};

struct TrJob { const float* W; const float* gs; bf16* WT; int ldw, k0, ns, nvalid, ldk, nd; };
struct TrRegs { f32x4 v[8]; f32x4 g0, g1; };
__device__ __forceinline__ void tr_load(TrRegs& R, const TrJob& j, int lane) {
    const int col4 = (lane & 7) * 4, r0 = lane >> 3;
#pragma unroll
    for (int i = 0; i < 8; ++i) { f32x4 v = {0.f, 0.f, 0.f, 0.f}; if (col4 < j.nvalid) v = *(const f32x4*)(j.W + (size_t)(j.k0 + 8 * i + r0) * j.ldw + j.ns + col4); R.v[i] = v; }
    R.g0 = (f32x4){1.f, 1.f, 1.f, 1.f}; R.g1 = R.g0;
    if (j.gs) { R.g0 = *(const f32x4*)(j.gs + j.k0 + 8 * (lane & 7)); R.g1 = *(const f32x4*)(j.gs + j.k0 + 8 * (lane & 7) + 4); }
}
__device__ __forceinline__ void tr_store(const TrRegs& R, const TrJob& j, LAS float* scr, int lane) {
    const int col4 = (lane & 7) * 4, r0 = lane >> 3;
#pragma unroll
    for (int i = 0; i < 8; ++i) { LAS float* d = scr + (8 * i + r0) * 33 + col4; d[0] = R.v[i][0]; d[1] = R.v[i][1]; d[2] = R.v[i][2]; d[3] = R.v[i][3]; }
    LDS_WAIT();
    const int c = lane & 7;
#pragma unroll
    for (int jj = 0; jj < 4; ++jj) { const int n = (lane >> 3) + 8 * jj; const LAS float* s = scr + (8 * c) * 33 + n;
        u32x4 o; o.x = cvt_pk_bf16(s[0 * 33] * R.g0[0], s[1 * 33] * R.g0[1]); o.y = cvt_pk_bf16(s[2 * 33] * R.g0[2], s[3 * 33] * R.g0[3]); o.z = cvt_pk_bf16(s[4 * 33] * R.g1[0], s[5 * 33] * R.g1[1]); o.w = cvt_pk_bf16(s[6 * 33] * R.g1[2], s[7 * 33] * R.g1[3]);
        *(u32x4*)(j.WT + (size_t)(j.nd + n) * j.ldk + j.k0 + 8 * c) = o; }
    LDS_WAIT();
}
constexpr int IT_IN1 = 64 * 416, IT_IN2 = 64 * 480, IT_ING = 64 * 2, IT_UA = 32 * 128, IT_UX = 8 * 128, IT_O = 64 * 128, IT_MKV = 64 * 32, IT_W1 = 64 * 4, IT_W2 = 2 * 4;
constexpr int IT_LAYER = IT_IN1 + IT_IN2 + IT_ING + 2 * IT_UA + IT_UX + IT_O + 2 * IT_W1 + 2 * IT_W2;
constexpr int TR_ITEMS = NLAY * IT_LAYER, TRCH = 16;
__device__ __forceinline__ TrJob tr_decode(const Ctx& C, int it) {
    TrJob j; const int l = it / IT_LAYER; int r = it - l * IT_LAYER; j.gs = nullptr; j.nvalid = 32;
    if (r < IT_IN1 + IT_IN2 + IT_ING) { j.W = C.w_in + (size_t)l * DM * INW; j.ldw = INW; j.gs = C.norm_g + l * DM; j.WT = C.Win_t() + (size_t)l * NP * DM; j.ldk = DM;
        if (r < IT_IN1) { j.k0 = 64 * (r / 416); j.ns = 32 * (r % 416); j.nd = j.ns; return j; } r -= IT_IN1;
        if (r < IT_IN2) { j.k0 = 64 * (r / 480); j.ns = S_NZ + 32 * (r % 480); j.nd = C_NZ + 32 * (r % 480); return j; } r -= IT_IN2;
        j.k0 = 64 * (r >> 1); j.ns = S_NG + 32 * (r & 1); j.nvalid = (r & 1) ? 16 : 32; j.WT = C.Wg_t() + (size_t)l * 64 * DM; j.nd = 32 * (r & 1); return j; }
    r -= IT_IN1 + IT_IN2 + IT_ING;
    if (r < IT_UA) { j.W = C.w_up_a + (size_t)l * 2048 * DM; j.ldw = DM; j.k0 = 64 * (r / 128); j.ns = 32 * (r % 128); j.WT = C.Wup_t() + (size_t)l * DM * YK; j.ldk = YK; j.nd = j.ns; return j; } r -= IT_UA;
    if (r < IT_UA) { j.W = C.w_up_b + (size_t)l * 2048 * DM; j.ldw = DM; j.k0 = 64 * (r / 128); j.ns = 32 * (r % 128); j.WT = C.Wup_t() + (size_t)l * DM * YK + 2048; j.ldk = YK; j.nd = j.ns; return j; } r -= IT_UA;
    if (r < IT_UX) { j.W = C.w_up_x + (size_t)l * 512 * DM; j.ldw = DM; j.k0 = 64 * (r / 128); j.ns = 32 * (r % 128); j.WT = C.Wup_t() + (size_t)l * DM * YK + 4096; j.ldk = YK; j.nd = j.ns; return j; } r -= IT_UX;
    if (r < IT_O) { j.W = C.w_out + (size_t)l * DM * DM; j.ldw = DM; j.k0 = 64 * (r / 128); j.ns = 32 * (r % 128); j.WT = C.Wo_t() + (size_t)l * DM * DM; j.ldk = DM; j.nd = j.ns; return j; } r -= IT_O;
    if (r < 2 * IT_W1) { const int c = r / IT_W1; r -= c * IT_W1; j.W = C.cmp_w1 + (size_t)(l * 2 + c) * 4096 * 128; j.ldw = 128; j.k0 = 64 * (r >> 2); j.ns = 32 * (r & 3); j.WT = C.W1_t() + (size_t)(l * 2 + c) * 128 * 4096; j.ldk = 4096; j.nd = j.ns; return j; } r -= 2 * IT_W1;
    { const int c = r / IT_W2; r -= c * IT_W2; j.W = C.cmp_w2 + (size_t)(l * 2 + c) * 128 * 128; j.ldw = 128; j.k0 = 64 * (r >> 2); j.ns = 32 * (r & 3); j.WT = C.W2_t() + (size_t)(l * 2 + c) * 128 * 128; j.ldk = 128; j.nd = j.ns; return j; }
}
__device__ __forceinline__ void p0_prologue(const Ctx& C, LAS unsigned char* lds) {
    const int tid = tid_now(), lane = tid & 63, wave = __builtin_amdgcn_readfirstlane(tid >> 6);
    LAS float* scr = (LAS float*)(lds + wave * 16384);
    const int gw = blockIdx.x * NWAVES + wave, NGW = C.G * NWAVES;
    for (int it = gw; it < NLAY * IT_MKV; it += NGW) { const int l = it / IT_MKV, r = it - l * IT_MKV;
        TrJob j; j.W = C.w_mem_kv + (size_t)l * DM * 1024; j.gs = C.mem_norm_g + l * DM; j.WT = C.Wmkv_t(); j.ldw = 1024; j.k0 = 64 * (r >> 5); j.ns = 32 * (r & 31); j.nvalid = 32; j.ldk = DM; j.nd = l * 1024 + j.ns;
        TrRegs R; tr_load(R, j, lane); tr_store(R, j, scr, lane); }
    for (int row = gw; row < TOK; row += NGW) {
        const f32x4* xr = (const f32x4*)(C.x + (size_t)row * DM) + lane; u32x2* ob = (u32x2*)(C.xb() + (size_t)row * DM) + lane; float ss = 0.f;
#pragma unroll
        for (int j = 0; j < 16; ++j) { const f32x4 v = xr[64 * j]; ss += (v[0] * v[0] + v[1] * v[1]) + (v[2] * v[2] + v[3] * v[3]); u32x2 o; o.x = cvt_pk_bf16(v[0], v[1]); o.y = cvt_pk_bf16(v[2], v[3]); ob[64 * j] = o; }
        C.ssqp()[(size_t)row * 64 + lane] = ss;
    }
    for (int row = gw; row < NBAT * 256; row += NGW) {
        const f32x4* xr = (const f32x4*)(C.mem + (size_t)row * DM) + lane; u32x2* ob = (u32x2*)(C.memb() + (size_t)row * DM) + lane; float ss = 0.f;
#pragma unroll
        for (int j = 0; j < 16; ++j) { const f32x4 v = xr[64 * j]; ss += (v[0] * v[0] + v[1] * v[1]) + (v[2] * v[2] + v[3] * v[3]); u32x2 o; o.x = cvt_pk_bf16(v[0], v[1]); o.y = cvt_pk_bf16(v[2], v[3]); ob[64 * j] = o; }
        ss = wave_sum(ss);
        if (lane == 0) C.rstdm()[row] = 1.0f / sqrtf(ss * (1.0f / DM) + EPS);
    }
}
__device__ __forceinline__ void p0_tables(const Ctx& C) {
    const int tid = tid_now(), lane = tid & 63, wave = __builtin_amdgcn_readfirstlane(tid >> 6);
    const int gw = blockIdx.x * NWAVES + wave, NGW = C.G * NWAVES;
    for (int e = blockIdx.x * 512 + tid; e < SEQ * 64; e += C.G * 512) {
        const int s = e >> 6, i = e & 63;
        double f = 1.0; const double rr = 0.86596432336006535;
        for (int k = 0; k < i; ++k) f *= rr;
        const double a = (double)s * f; const double TWO_PI = 6.283185307179586476925;
        const double kq = __builtin_rint(a / TWO_PI); const double t = a - kq * TWO_PI, t2 = t * t;
        double cs = 1.0, sn = t, term_c = 1.0, term_s = t;
#pragma unroll 1
        for (int k = 1; k <= 13; ++k) { term_c *= -t2 / (double)((2 * k - 1) * (2 * k)); term_s *= -t2 / (double)((2 * k) * (2 * k + 1)); cs += term_c; sn += term_s; }
        C.cost()[e] = (float)cs; C.sint()[e] = (float)sn;
    }
    for (int o = gw; o < NLAY * 2 * 128; o += NGW) {
        const int lc = o >> 7, j = o & 127; const float* pp = C.cmp_pos + (size_t)lc * 4096; const float* ww = C.cmp_w1 + (size_t)lc * 4096 * 128 + j; float s = 0.f;
        { float s1 = 0.f, s2 = 0.f, s3 = 0.f;
#pragma unroll 4
          for (int f = lane; f < 4096; f += 256) { s += pp[f] * ww[(size_t)f * 128]; s1 += pp[f + 64] * ww[(size_t)(f + 64) * 128]; s2 += pp[f + 128] * ww[(size_t)(f + 128) * 128]; s3 += pp[f + 192] * ww[(size_t)(f + 192) * 128]; }
          s = (s + s1) + (s2 + s3); }
        s = wave_sum(s);
        if (lane == 0) C.pb()[o] = s;
    }
}
__device__ __forceinline__ void p0_convert(const Ctx& C, LAS unsigned char* lds, unsigned* qctr) {
    const int tid = tid_now(), lane = tid & 63, wave = __builtin_amdgcn_readfirstlane(tid >> 6);
    LAS float* scr = (LAS float*)(lds + wave * 16384);
    int qcur = 0, qend = 0;
#define TR_NEXT(dst) do { if (qcur == qend) { int b_ = 0; if (lane == 0) b_ = (int)atomicAdd(qctr, (unsigned)TRCH); b_ = __builtin_amdgcn_readfirstlane(b_); qcur = b_; qend = (b_ + TRCH < TR_ITEMS) ? b_ + TRCH : TR_ITEMS; } \
        if (qcur < qend) { dst = qcur; ++qcur; } else { dst = -1; qend = qcur; } } while (0)
    int it; TR_NEXT(it);
    if (it >= 0) {
        TrJob cur = tr_decode(C, it); TrRegs A; tr_load(A, cur, lane);
        for (;;) {
            int nx; TR_NEXT(nx); TrJob nj = cur; TrRegs B = A;
            if (nx >= 0) { nj = tr_decode(C, nx); tr_load(B, nj, lane); }
            tr_store(A, cur, scr, lane);
            if (nx < 0) break;
            cur = nj; A = B;
        }
    }
#undef TR_NEXT
}

__device__ __forceinline__ void rstd_phase(const Ctx& C) {
    const int tid = tid_now(), lane = tid & 63, wave = tid >> 6; const int gw = blockIdx.x * NWAVES + wave, NGW = C.G * NWAVES;
    for (int row0 = gw; row0 < TOK; row0 += 4 * NGW) { float v[4];
#pragma unroll
        for (int k = 0; k < 4; ++k) { const int row = row0 + k * NGW; v[k] = row < TOK ? C.ssqp()[(size_t)row * 64 + lane] : 0.f; }
#pragma unroll
        for (int k = 0; k < 4; ++k) { const int row = row0 + k * NGW; const float s = wave_sum(v[k]); if (lane == 0 && row < TOK) C.rstd()[row] = 1.0f / sqrtf(s * (1.0f / DM) + EPS); } }
}
__device__ __forceinline__ void final_phase(const Ctx& C) {
    const int tid = tid_now(), lane = tid & 63, wave = tid >> 6; const int gw = blockIdx.x * NWAVES + wave, NGW = C.G * NWAVES;
    for (int row = gw; row < TOK; row += NGW) {
        const float s = wave_sum(C.ssqp()[(size_t)row * 64 + lane]); const float rs = 1.0f / sqrtf(s * (1.0f / DM) + EPS);
        const u32x2* xr = (const u32x2*)(C.xb() + (size_t)row * DM) + lane; f32x4* orow = (f32x4*)(C.out + (size_t)row * DM) + lane; const f32x4* gr = (const f32x4*)C.final_g + lane;
#pragma unroll
        for (int j = 0; j < 16; ++j) { const u32x2 xv = xr[64 * j]; const f32x4 v = {bflo(xv.x), bfhi(xv.x), bflo(xv.y), bfhi(xv.y)}; orow[64 * j] = v * rs * gr[64 * j]; }
    }
}

constexpr float SL2 = 0.08838834764831845f * 1.4426950408889634f;
#define MFMA32(a, b, c) __builtin_amdgcn_mfma_f32_32x32x16_bf16((a), (b), (c), 0, 0, 0)
#define MFMA16(a, b, c) __builtin_amdgcn_mfma_f32_16x16x32_bf16((a), (b), (c), 0, 0, 0)
__device__ __forceinline__ void dma_k(LAS unsigned char* kb, const bf16* Kp, int kpitch, int tid, int w) {
#pragma unroll
    for (int q = 0; q < 2; ++q) { const int p = q * 512 + tid, row = p >> 4, c = (p & 15) ^ (row & 15);
        __builtin_amdgcn_global_load_lds((const unsigned*)(Kp + (size_t)row * kpitch + c * 8), (LAS unsigned*)(kb + (q * 512 + w * 64) * 16), 16, 0, 0); }
}
__device__ __forceinline__ void dma_v(LAS unsigned char* vb, const bf16* Vtp, int vts, int tid, int w) {
#pragma unroll
    for (int q = 0; q < 2; ++q) { const int p = q * 512 + tid, d = p >> 3, c = (p & 7) ^ ((d >> 1) & 7);
        __builtin_amdgcn_global_load_lds((const unsigned*)(Vtp + (size_t)d * vts + c * 8), (LAS unsigned*)(vb + (q * 512 + w * 64) * 16), 16, 0, 0); }
}
template <int s> __device__ __forceinline__ bf16x8 pack_step(const f32x16& x) {
    u32x4 p; p.x = cvt_pk_bf16(x[8 * s], x[8 * s + 1]); p.y = cvt_pk_bf16(x[8 * s + 2], x[8 * s + 3]); p.z = cvt_pk_bf16(x[8 * s + 4], x[8 * s + 5]); p.w = cvt_pk_bf16(x[8 * s + 6], x[8 * s + 7]);
    return __builtin_bit_cast(bf16x8, p);
}
__device__ __forceinline__ void qk_tile(f32x16& S0, f32x16& S1, const bf16x8 (&qf)[8], LAS const unsigned char* kb, int lane) {
    const int row = lane & 31, hi = lane >> 5, x = row & 15;
    LAS const unsigned char* kp = kb + row * 256;
#pragma unroll
    for (int r = 0; r < 16; ++r) { S0[r] = 0.f; S1[r] = 0.f; }
#pragma unroll
    for (int st = 0; st < 8; ++st) { const int off = ((2 * st + hi) ^ x) * 16; const bf16x8 k0 = *(LAS const bf16x8*)(kp + off); const bf16x8 k1 = *(LAS const bf16x8*)(kp + 32 * 256 + off);
        S0 = MFMA32(k0, qf[st], S0); S1 = MFMA32(k1, qf[st], S1); }
}
template <int MODE> __device__ __forceinline__ void mask_raw(f32x16& S0, f32x16& S1, int kbase, int tq, int hi) {
    const float NINF = -__builtin_inff();
#pragma unroll
    for (int r = 0; r < 16; ++r) { const int k0 = kbase + (r & 3) + 8 * (r >> 2) + 4 * hi, k1 = k0 + 32;
        if (MODE == 1) { if (16 * k0 + 31 > tq) S0[r] = NINF; if (16 * k1 + 31 > tq) S1[r] = NINF; }
        if (MODE == 2) { if (k0 > tq) S0[r] = NINF; if (k1 > tq) S1[r] = NINF; }
        if (MODE == 3) { if ((unsigned)(tq - k0) >= 512u) S0[r] = NINF; if ((unsigned)(tq - k1) >= 512u) S1[r] = NINF; } }
}
constexpr float DEFER_THR = 8.0f;
template <int MODE> __device__ __forceinline__ void attn_tile(f32x16 (&O)[4], float& m, float& l, const bf16x8 (&qf)[8], LAS const unsigned char* kb, LAS const unsigned char* vb,
                                                                           int lane, int kbase, int tq, bool selbit, bool masked) {
    const float NINF = -__builtin_inff();
    f32x16 S0, S1;
    qk_tile(S0, S1, qf, kb, lane);
    if (MODE != 0 && masked) mask_raw<MODE>(S0, S1, kbase, tq, lane >> 5);
    float mt = NINF;
#pragma unroll
    for (int r = 0; r < 16; ++r) mt = fmaxf(mt, fmaxf(S0[r], S1[r]));
    mt = fmaxf(mt, __shfl_xor(mt, 32)) * SL2;
    if (MODE == 2) mt = selbit ? mt : NINF;
    const bool need = mt > m + DEFER_THR;
    if (__builtin_amdgcn_ballot_w64(need) != 0ull) {
        const float mn = need ? mt : m; const float alpha = __builtin_amdgcn_exp2f(m - mn); m = mn; l *= alpha;
#pragma unroll
        for (int db = 0; db < 4; ++db) O[db] = O[db] * alpha;
    }
    float nb = -m; if (MODE == 2) nb = selbit ? nb : NINF;
    float ls = 0.f;
#pragma unroll
    for (int r = 0; r < 16; ++r) { S0[r] = __builtin_amdgcn_exp2f(__builtin_fmaf(S0[r], SL2, nb)); S1[r] = __builtin_amdgcn_exp2f(__builtin_fmaf(S1[r], SL2, nb)); ls += S0[r] + S1[r]; }
    l += ls;
    const int vrow = lane & 31, vhi = lane >> 5, vx = (vrow >> 1) & 7;
    LAS const unsigned char* vp = vb + vrow * 128;
#define PV_STEP(st4, pfexpr) { const bf16x8 pf = pfexpr; const int voff = ((2 * (st4) + vhi) ^ vx) * 16; _Pragma("unroll") for (int db = 0; db < 4; ++db) { const bf16x8 vf = *(LAS const bf16x8*)(vp + db * 32 * 128 + voff); O[db] = MFMA32(vf, pf, O[db]); } }
    PV_STEP(0, pack_step<0>(S0)) PV_STEP(1, pack_step<1>(S0)) PV_STEP(2, pack_step<0>(S1)) PV_STEP(3, pack_step<1>(S1))
#undef PV_STEP
}
template <int MODE> __device__ __forceinline__ void attn_branch(f32x16 (&O)[4], float& m, float& l, const bf16x8 (&qf)[8], LAS unsigned char* lds, const bf16* Kb, int kpitch, const bf16* Vtb, int vts,
                                                                int jlo, int jhi, int tq, unsigned selmask, int tid, int lane, int w) {
    dma_k(lds + A_KB0, Kb + (size_t)jlo * 64 * kpitch, kpitch, tid, w); dma_v(lds + A_VB0, Vtb + jlo * 64, vts, tid, w);
    asm volatile("s_waitcnt vmcnt(0)" ::: "memory");
    __syncthreads();
    int buf = 0;
    for (int j = jlo; j <= jhi; ++j) {
        if (j < jhi) { dma_k(lds + (buf ? A_KB0 : A_KB1), Kb + (size_t)(j + 1) * 64 * kpitch, kpitch, tid, w); dma_v(lds + (buf ? A_VB0 : A_VB1), Vtb + (j + 1) * 64, vts, tid, w); }
        const bool masked = (MODE == 1) || (MODE == 2 && j == jhi) || (MODE == 3 && (j == jlo || j == jhi));
        attn_tile<MODE>(O, m, l, qf, lds + (buf ? A_KB1 : A_KB0), lds + (buf ? A_VB1 : A_VB0), lane, j * 64, tq, ((selmask >> j) & 1u) != 0u, masked);
        asm volatile("s_waitcnt vmcnt(0)" ::: "memory");
        __syncthreads();
        buf ^= 1;
    }
}
__device__ __forceinline__ void load_q(bf16x8 (&qf)[8], const bf16* qp  ) {
#pragma unroll
    for (int st = 0; st < 8; ++st) qf[st] = *(const bf16x8*)(qp + st * 16);
}
__device__ __forceinline__ float branch_inv(float l) { const float lt = l + __shfl_xor(l, 32); return lt > 0.f ? 1.0f / lt : 0.f; }

__device__ __forceinline__ void nsa_unit(const Ctx& C, int b, int g, int qb, LAS unsigned char* lds) {
    const int tid = tid_now(), lane = tid & 63, w = __builtin_amdgcn_readfirstlane(tid >> 6), hh = w >> 1, th = w & 1, c = lane & 31, hi = lane >> 5;
    const int tq = 64 * qb + 32 * th + c, head = g * 4 + hh; const size_t row = (size_t)b * SEQ + tq;
    const bf16* prow = C.P() + row * NP;
    bf16x8 qf[8];
    load_q(qf, prow + C_NQ + head * 128 + hi * 8);
    const float* ngp = C.ng() + row * 48 + head * 3; const float g0 = ngp[0], g1 = ngp[1], g2 = ngp[2];
    const size_t bg = (size_t)(b * 4 + g);
    f32x16 O[4]; float m, l;
    unsigned* tsc = C.tsc() + ((size_t)(blockIdx.x * NWAVES + w) * 32) * 64 + lane;
#pragma unroll
    for (int db = 0; db < 4; ++db)
#pragma unroll
        for (int r = 0; r < 16; ++r) O[db][r] = 0.f;
    m = -1e30f; l = 0.f;
    const bf16* Kc = C.Kc() + bg * 128 * 128; const bf16* Vtc = C.Vtc() + bg * 128 * 128;
    attn_branch<1>(O, m, l, qf, lds, Kc, 128, Vtc, 128, 0, (qb >= 16) ? 1 : 0, tq, 0u, tid, lane, w);
    const float inv0 = branch_inv(l);
    { const float sc = g0 * inv0;
#pragma unroll
      for (int db = 0; db < 4; ++db)
#pragma unroll
          for (int r = 0; r < 8; ++r) tsc[(db * 8 + r) * 64] = cvt_pk_bf16(O[db][2 * r] * sc, O[db][2 * r + 1] * sc); }
    unsigned selmask = 0xffffffffu;
    if (qb >= 16) {
        dma_k(lds + A_KB0, Kc, 128, tid, w); dma_k(lds + A_KB1, Kc + 64 * 128, 128, tid, w);
        asm volatile("s_waitcnt vmcnt(0)" ::: "memory");
        __syncthreads();
        float Gv[16], Ev[16];
#pragma unroll
        for (int t = 0; t < 2; ++t) {
            f32x16 S0, S1;
            qk_tile(S0, S1, qf, lds + (t ? A_KB1 : A_KB0), lane);
            mask_raw<1>(S0, S1, 64 * t, tq, hi);
#pragma unroll
            for (int r = 0; r < 16; ++r) { S0[r] = __builtin_amdgcn_exp2f(__builtin_fmaf(S0[r], SL2, -m)) * inv0; S1[r] = __builtin_amdgcn_exp2f(__builtin_fmaf(S1[r], SL2, -m)) * inv0; }
#pragma unroll
            for (int q4 = 0; q4 < 4; ++q4) {
                Gv[8 * t + q4] = (S0[4 * q4] + S0[4 * q4 + 1]) + (S0[4 * q4 + 2] + S0[4 * q4 + 3]); Ev[8 * t + q4] = S0[4 * q4 + 3];
                Gv[8 * t + 4 + q4] = (S1[4 * q4] + S1[4 * q4 + 1]) + (S1[4 * q4 + 2] + S1[4 * q4 + 3]); Ev[8 * t + 4 + q4] = S1[4 * q4 + 3]; }
        }
        float rv[16];
#pragma unroll
        for (int i = 0; i < 16; ++i) rv[i] = __shfl_xor(Ev[i], 32);
        LAS float* impw = (LAS float*)(lds + A_IMPW) + (w * 32 + c) * 33;
#pragma unroll
        for (int i = 0; i < 16; ++i) { const float add = hi ? rv[i] : (i > 0 ? rv[i > 0 ? i - 1 : 0] : 0.f); impw[2 * i + hi] = Gv[i] + add; }
        __syncthreads();
        {
            const int tk = tid >> 3, part = tid & 7, tth = tk >> 5, cc = tk & 31; LAS const float* iw = (LAS const float*)(lds + A_IMPW); LAS float* is = (LAS float*)(lds + A_IMPS);
#pragma unroll
            for (int jj = 0; jj < 4; ++jj) { const int j = 4 * part + jj; float s = 0.f;
#pragma unroll
                for (int h4 = 0; h4 < 4; ++h4) s += iw[((2 * h4 + tth) * 32 + cc) * 33 + j];
                is[tk * 33 + j] = s; }
        }
        __syncthreads();
        {
            const int tk = tid >> 3, part = tid & 7; LAS const float* is = (LAS const float*)(lds + A_IMPS) + tk * 33; const float PINF = __builtin_inff();
            unsigned bits = 0u;
#pragma unroll
            for (int jj = 0; jj < 4; ++jj) { const int j = 4 * part + jj;
                const float vj = (j > qb) ? -PINF : ((j == 0 || j == qb || j == qb - 1) ? PINF : is[j]); int cnt = 0;
                for (int k = 0; k < 32; ++k) { const float vk = (k > qb) ? -PINF : ((k == 0 || k == qb || k == qb - 1) ? PINF : is[k]); cnt += (vk > vj || (vk == vj && k < j)) ? 1 : 0; }
                if (cnt < 16) bits |= 1u << j; }
            bits |= __shfl_xor(bits, 1); bits |= __shfl_xor(bits, 2); bits |= __shfl_xor(bits, 4);
            if (part == 0) ((LAS unsigned*)(lds + A_SELM))[tk] = bits;
        }
        __syncthreads();
        selmask = ((LAS const unsigned*)(lds + A_SELM))[32 * th + c];
    }
    { const float* cs = C.cost() + (size_t)tq * 64 + hi * 8; const float* sn = C.sint() + (size_t)tq * 64 + hi * 8;
#pragma unroll
      for (int st = 0; st < 4; ++st) {
          const f32x4 c0 = *(const f32x4*)(cs + st * 16), c1 = *(const f32x4*)(cs + st * 16 + 4), s0 = *(const f32x4*)(sn + st * 16), s1 = *(const f32x4*)(sn + st * 16 + 4);
          const u32x4 a = __builtin_bit_cast(u32x4, qf[st]), bq = __builtin_bit_cast(u32x4, qf[st + 4]); u32x4 oa, ob;
#pragma unroll
          for (int e2 = 0; e2 < 4; ++e2) { const float x1l = bflo(a[e2]), x1h = bfhi(a[e2]), x2l = bflo(bq[e2]), x2h = bfhi(bq[e2]);
              const float cl = (e2 < 2) ? c0[2 * e2] : c1[2 * e2 - 4], ch = (e2 < 2) ? c0[2 * e2 + 1] : c1[2 * e2 - 3], sl = (e2 < 2) ? s0[2 * e2] : s1[2 * e2 - 4], sh = (e2 < 2) ? s0[2 * e2 + 1] : s1[2 * e2 - 3];
              oa[e2] = cvt_pk_bf16(x1l * cl - x2l * sl, x1h * ch - x2h * sh); ob[e2] = cvt_pk_bf16(x2l * cl + x1l * sl, x2h * ch + x1h * sh); }
          qf[st] = __builtin_bit_cast(bf16x8, oa); qf[st + 4] = __builtin_bit_cast(bf16x8, ob); } }
#pragma unroll
    for (int db = 0; db < 4; ++db)
#pragma unroll
        for (int r = 0; r < 16; ++r) O[db][r] = 0.f;
    m = -1e30f; l = 0.f;
    attn_branch<2>(O, m, l, qf, lds, C.Kr() + bg * SEQ * 128, 128, C.Vt() + bg * 128 * SEQ, SEQ, 0, qb, tq, selmask, tid, lane, w);
    { const float sc = g1 * branch_inv(l);
#pragma unroll
      for (int db = 0; db < 4; ++db)
#pragma unroll
          for (int r = 0; r < 8; ++r) { const unsigned t = tsc[(db * 8 + r) * 64]; tsc[(db * 8 + r) * 64] = cvt_pk_bf16(bflo(t) + O[db][2 * r] * sc, bfhi(t) + O[db][2 * r + 1] * sc); } }
#pragma unroll
    for (int db = 0; db < 4; ++db)
#pragma unroll
        for (int r = 0; r < 16; ++r) O[db][r] = 0.f;
    m = -1e30f; l = 0.f;
    attn_branch<3>(O, m, l, qf, lds, C.Kr() + (16 + bg) * SEQ * 128, 128, C.Vt() + (16 + bg) * 128 * SEQ, SEQ, (qb > 8) ? qb - 8 : 0, qb, tq, 0u, tid, lane, w);
    { const float sc = g2 * branch_inv(l);
      const bf16* zp = prow + C_NZ + head * 128 + 4 * hi; bf16* op = C.Y() + row * YK + 2048 + head * 128 + 4 * hi;
#pragma unroll
      for (int db = 0; db < 4; ++db)
#pragma unroll
          for (int q4 = 0; q4 < 4; ++q4) { const u32x2 zz = *(const u32x2*)(zp + 32 * db + 8 * q4); const unsigned t0 = tsc[(db * 8 + 2 * q4) * 64], t1 = tsc[(db * 8 + 2 * q4 + 1) * 64];
              const float o0 = (bflo(t0) + O[db][4 * q4] * sc) * siluf_(bflo(zz.x)), o1 = (bfhi(t0) + O[db][4 * q4 + 1] * sc) * siluf_(bfhi(zz.x));
              const float o2 = (bflo(t1) + O[db][4 * q4 + 2] * sc) * siluf_(bflo(zz.y)), o3 = (bfhi(t1) + O[db][4 * q4 + 3] * sc) * siluf_(bfhi(zz.y));
              u32x2 ov; ov.x = cvt_pk_bf16(o0, o1); ov.y = cvt_pk_bf16(o2, o3); *(u32x2*)(op + 32 * db + 8 * q4) = ov; } }
}

__device__ __forceinline__ void mem_unit(const Ctx& C, int l_, int b, int h, int tb, LAS unsigned char* lds) {
    const int tid = tid_now(), lane = tid & 63, w = __builtin_amdgcn_readfirstlane(tid >> 6), c = lane & 31, hi = lane >> 5;
    const int tq = 256 * tb + 32 * w + c; const size_t row = (size_t)b * SEQ + tq; const bf16* prow = C.P() + row * NP;
    bf16x8 qf[8];
    load_q(qf, prow + C_XQ + h * 128 + hi * 8);
    f32x16 O[4]; float m = -1e30f, l = 0.f;
#pragma unroll
    for (int db = 0; db < 4; ++db)
#pragma unroll
        for (int r = 0; r < 16; ++r) O[db][r] = 0.f;
    const size_t hb = (size_t)((l_ * 4 + b) * 4 + h);
    attn_branch<0>(O, m, l, qf, lds, C.memK() + hb * 256 * 128, 128, C.memVt() + hb * 128 * 256, 256, 0, 3, tq, 0u, tid, lane, w);
    const float sc = branch_inv(l);
    const bf16* zp = prow + C_XZ + h * 128 + 4 * hi; bf16* op = C.Y() + row * YK + 4096 + h * 128 + 4 * hi;
#pragma unroll
    for (int db = 0; db < 4; ++db)
#pragma unroll
        for (int q4 = 0; q4 < 4; ++q4) { const u32x2 zz = *(const u32x2*)(zp + 32 * db + 8 * q4);
            u32x2 ov; ov.x = cvt_pk_bf16(O[db][4 * q4] * sc * siluf_(bflo(zz.x)), O[db][4 * q4 + 1] * sc * siluf_(bfhi(zz.x)));
            ov.y = cvt_pk_bf16(O[db][4 * q4 + 2] * sc * siluf_(bflo(zz.y)), O[db][4 * q4 + 3] * sc * siluf_(bfhi(zz.y))); *(u32x2*)(op + 32 * db + 8 * q4) = ov; }
}

__device__ __forceinline__ void cmp_item(const Ctx& C, int l_, int item, LAS unsigned char* lds) {
    const int tid = tid_now(), lane = tid & 63, w = __builtin_amdgcn_readfirstlane(tid >> 6), r16 = lane & 15, quad = lane >> 4;
    const int nb = item & 7, c = (item >> 3) & 1, g = (item >> 4) & 3, b = item >> 6, n0 = 16 * nb;
    int n = n0 + r16; if (n > 126) n = 126;
    f32x4 acc[8];
#pragma unroll
    for (int cb = 0; cb < 8; ++cb) acc[cb] = (f32x4){0.f, 0.f, 0.f, 0.f};
    const bf16* W1 = C.W1_t() + (size_t)(l_ * 2 + c) * 128 * 4096;
    const bf16* abase = C.P() + ((size_t)b * SEQ + 16 * n) * NP + C_KV + (c * 4 + g) * 128 + quad * 8;
    bf16x8 av[4][4];
#pragma unroll
    for (int ll = 0; ll < 4; ++ll)
#pragma unroll
        for (int ks = 0; ks < 4; ++ks) av[ll][ks] = *(const bf16x8*)(abase + (size_t)(4 * w + ll) * NP + ks * 32);
#pragma unroll
    for (int ll = 0; ll < 4; ++ll) { const int lpos = 4 * w + ll; const bf16* bp = W1 + (size_t)r16 * 4096 + lpos * 128 + quad * 8;
#pragma unroll
        for (int ks = 0; ks < 4; ++ks) { bf16x8 bv[8];
#pragma unroll
            for (int cb = 0; cb < 8; ++cb) bv[cb] = *(const bf16x8*)(bp + (size_t)cb * 16 * 4096 + ks * 32);
#pragma unroll
            for (int cb = 0; cb < 8; ++cb) acc[cb] = MFMA16(av[ll][ks], bv[cb], acc[cb]); } }
    LAS float* red = (LAS float*)lds;
#pragma unroll
    for (int cb = 0; cb < 8; ++cb)
#pragma unroll
        for (int i = 0; i < 4; ++i) red[(w * 16 + 4 * quad + i) * 128 + 16 * cb + r16] = acc[cb][i];
    __syncthreads();
    LAS bf16* hid = (LAS bf16*)(lds + 65536);
#pragma unroll
    for (int q = 0; q < 4; ++q) { const int o = tid + 512 * q, rr = o >> 7, col = o & 127; float s = C.pb()[(l_ * 2 + c) * 128 + col];
#pragma unroll
        for (int ww = 0; ww < 8; ++ww) s += red[(ww * 16 + rr) * 128 + col];
        hid[rr * 136 + col] = f2bf(siluf_(s)); }
    __syncthreads();
    const bf16* W2 = C.W2_t() + (size_t)(l_ * 2 + c) * 128 * 128; f32x4 a2 = (f32x4){0.f, 0.f, 0.f, 0.f};
#pragma unroll
    for (int ks = 0; ks < 4; ++ks) { const bf16x8 a = *(LAS const bf16x8*)(hid + r16 * 136 + ks * 32 + quad * 8); const bf16x8 bb = *(const bf16x8*)(W2 + (size_t)(16 * w + r16) * 128 + ks * 32 + quad * 8); a2 = MFMA16(a, bb, a2); }
    const size_t bg = (size_t)(b * 4 + g); const int col = 16 * w + r16;
#pragma unroll
    for (int i = 0; i < 4; ++i) { const int nn = n0 + 4 * quad + i; const bf16 v = f2bf(nn < 127 ? a2[i] : 0.f);
        if (c == 0) C.Kc()[(bg * 128 + nn) * 128 + col] = v; else C.Vtc()[(bg * 128 + col) * 128 + ((nn & ~15) | perm16(nn & 15))] = v; }
    __syncthreads();
}
__device__ __forceinline__ void ropevt_item(const Ctx& C, int item, LAS unsigned char* lds) {
    const int tid = tid_now(); const int j0 = (item & 7) * 4, g = (item >> 3) & 3, b = (item >> 5) & 3, brk = item >> 7, br = brk + 1;
    const size_t bg = (size_t)(brk * 16 + b * 4 + g);
    {
        const int s = tid >> 3, d0 = 8 * (tid & 7); u32x4 a[4], bq[4]; f32x4 c0[4], c1[4], s0[4], s1[4];
#pragma unroll
        for (int u = 0; u < 4; ++u) { const int tok = 64 * (j0 + u) + s; const bf16* src = C.P() + ((size_t)b * SEQ + tok) * NP + C_KV + ((br * 2 + 0) * 4 + g) * 128 + d0;
            a[u] = *(const u32x4*)src; bq[u] = *(const u32x4*)(src + 64);
            const float* cs = C.cost() + (size_t)tok * 64 + d0; const float* sn = C.sint() + (size_t)tok * 64 + d0;
            c0[u] = *(const f32x4*)cs; c1[u] = *(const f32x4*)(cs + 4); s0[u] = *(const f32x4*)sn; s1[u] = *(const f32x4*)(sn + 4); }
#pragma unroll
        for (int u = 0; u < 4; ++u) { const int tok = 64 * (j0 + u) + s; u32x4 oa, ob;
#pragma unroll
            for (int e2 = 0; e2 < 4; ++e2) { const float x1l = bflo(a[u][e2]), x1h = bfhi(a[u][e2]), x2l = bflo(bq[u][e2]), x2h = bfhi(bq[u][e2]);
                const float cl = (e2 < 2) ? c0[u][2 * e2] : c1[u][2 * e2 - 4], ch = (e2 < 2) ? c0[u][2 * e2 + 1] : c1[u][2 * e2 - 3], sl = (e2 < 2) ? s0[u][2 * e2] : s1[u][2 * e2 - 4], sh = (e2 < 2) ? s0[u][2 * e2 + 1] : s1[u][2 * e2 - 3];
                oa[e2] = cvt_pk_bf16(x1l * cl - x2l * sl, x1h * ch - x2h * sh); ob[e2] = cvt_pk_bf16(x2l * cl + x1l * sl, x2h * ch + x1h * sh); }
            bf16* dst = C.Kr() + (bg * SEQ + tok) * 128 + d0; *(u32x4*)dst = oa; *(u32x4*)(dst + 64) = ob; }
    }
    {
        LAS bf16* vt = (LAS bf16*)lds; u32x4 v[8];
#pragma unroll
        for (int q = 0; q < 8; ++q) { const int id = tid + 512 * (q & 1), s = id >> 4, ch = id & 15, u = q >> 1;
            v[q] = *(const u32x4*)(C.P() + ((size_t)b * SEQ + 64 * (j0 + u) + s) * NP + C_KV + ((br * 2 + 1) * 4 + g) * 128 + ch * 8); }
#pragma unroll
        for (int q = 0; q < 8; ++q) { const int id = tid + 512 * (q & 1), s = id >> 4, ch = id & 15, u = q >> 1;
            LAS unsigned* d = (LAS unsigned*)(vt + u * (64 * 130) + s * 130 + ch * 8); d[0] = v[q].x; d[1] = v[q].y; d[2] = v[q].z; d[3] = v[q].w; }
        __syncthreads();
#pragma unroll
        for (int q = 0; q < 8; ++q) { const int id = tid + 512 * (q & 1), d = id >> 3, pc = id & 7, u = q >> 1; unsigned short e[8];
#pragma unroll
            for (int k = 0; k < 8; ++k) { const int key = 16 * (pc >> 1) + 8 * (k >> 2) + 4 * (pc & 1) + (k & 3); e[k] = vt[u * (64 * 130) + key * 130 + d]; }
            u32x4 o; o.x = e[0] | ((unsigned)e[1] << 16); o.y = e[2] | ((unsigned)e[3] << 16); o.z = e[4] | ((unsigned)e[5] << 16); o.w = e[6] | ((unsigned)e[7] << 16);
            *(u32x4*)(C.Vt() + (bg * 128 + d) * SEQ + 64 * (j0 + u) + 8 * pc) = o; }
        __syncthreads();
    }
}
__device__ __forceinline__ void gate_item(const Ctx& C, int l_, int item, LAS unsigned char* lds) {
    const int tid = tid_now(), lane = tid & 63, w = __builtin_amdgcn_readfirstlane(tid >> 6), r16 = lane & 15, quad = lane >> 4, rb = w >> 2, kq = w & 3;
    const bf16* ap = C.xb() + (size_t)(32 * item + 16 * rb + r16) * DM + kq * 1024 + quad * 8;
    const bf16* bp = C.Wg_t() + (size_t)l_ * 64 * DM + (size_t)r16 * DM + kq * 1024 + quad * 8;
    f32x4 acc[3];
#pragma unroll
    for (int cb = 0; cb < 3; ++cb) acc[cb] = (f32x4){0.f, 0.f, 0.f, 0.f};
#pragma unroll
    for (int k0 = 0; k0 < 32; k0 += 16) { bf16x8 ag[16];
#pragma unroll
        for (int ks = 0; ks < 16; ++ks) ag[ks] = *(const bf16x8*)(ap + (k0 + ks) * 32);
#pragma unroll
        for (int ks = 0; ks < 16; ++ks) {
#pragma unroll
            for (int cb = 0; cb < 3; ++cb) { const bf16x8 bb = *(const bf16x8*)(bp + (size_t)cb * 16 * DM + (k0 + ks) * 32); acc[cb] = MFMA16(ag[ks], bb, acc[cb]); } } }
    LAS float* red = (LAS float*)lds;
#pragma unroll
    for (int cb = 0; cb < 3; ++cb)
#pragma unroll
        for (int i = 0; i < 4; ++i) red[(w * 16 + 4 * quad + i) * 48 + 16 * cb + r16] = acc[cb][i];
    __syncthreads();
    for (int o = tid; o < 32 * 48; o += 512) { const int rr = o / 48, col = o - rr * 48, rb2 = rr >> 4, r2 = rr & 15; float s = 0.f;
#pragma unroll
        for (int q = 0; q < 4; ++q) s += red[((rb2 * 4 + q) * 16 + r2) * 48 + col];
        const int row = 32 * item + rr; C.ng()[(size_t)row * 48 + col] = sigmoidf_(s * C.rstd()[row]); }
    __syncthreads();
}
__device__ __forceinline__ void memvt_item(const Ctx& C, int item, LAS unsigned char* lds) {
    const int tid = tid_now(); const int t = item & 3, h = (item >> 2) & 3, b = (item >> 4) & 3, l_ = item >> 6;
    LAS bf16* vt = (LAS bf16*)lds;
#pragma unroll
    for (int q = 0; q < 2; ++q) { const int id = tid + 512 * q, s = id >> 4, ch = id & 15;
        *(u32x4*)(C.memK() + ((size_t)((l_ * 4 + b) * 4 + h) * 256 + 64 * t + s) * 128 + ch * 8) = *(const u32x4*)(C.MKV() + ((size_t)b * 256 + 64 * t + s) * 4096 + l_ * 1024 + h * 128 + ch * 8);
        const u32x4 v = *(const u32x4*)(C.MKV() + ((size_t)b * 256 + 64 * t + s) * 4096 + l_ * 1024 + 512 + h * 128 + ch * 8);
        LAS unsigned* d = (LAS unsigned*)(vt + s * 130 + ch * 8); d[0] = v.x; d[1] = v.y; d[2] = v.z; d[3] = v.w; }
    __syncthreads();
    const size_t hb = (size_t)((l_ * 4 + b) * 4 + h);
#pragma unroll
    for (int q = 0; q < 2; ++q) { const int id = tid + 512 * q, d = id >> 3, pc = id & 7; unsigned short e[8];
#pragma unroll
        for (int k = 0; k < 8; ++k) { const int key = 16 * (pc >> 1) + 8 * (k >> 2) + 4 * (pc & 1) + (k & 3); e[k] = vt[key * 130 + d]; }
        u32x4 o; o.x = e[0] | ((unsigned)e[1] << 16); o.y = e[2] | ((unsigned)e[3] << 16); o.z = e[4] | ((unsigned)e[5] << 16); o.w = e[6] | ((unsigned)e[7] << 16);
        *(u32x4*)(C.memVt() + (hb * 128 + d) * 256 + 64 * t + 8 * pc) = o; }
    __syncthreads();
}
__device__ __forceinline__ void conv_item(const Ctx& C, int l_, int item) {
    const int tid = tid_now(); const int ch = (tid & 255) * 8, t0 = 64 * item + 32 * (tid >> 8), sp0 = t0 & (SEQ - 1);
    const float* cw = C.conv_w + (size_t)l_ * 3 * 2048 + ch; const float* cbv = C.conv_b + (size_t)l_ * 2048 + ch;
    float w[3][8], bias[8], u1[8], u2[8];
#pragma unroll
    for (int k = 0; k < 3; ++k) { const f32x4 a = *(const f32x4*)(cw + k * 2048), c = *(const f32x4*)(cw + k * 2048 + 4); w[k][0] = a[0]; w[k][1] = a[1]; w[k][2] = a[2]; w[k][3] = a[3]; w[k][4] = c[0]; w[k][5] = c[1]; w[k][6] = c[2]; w[k][7] = c[3]; }
    { const f32x4 a = *(const f32x4*)cbv, c = *(const f32x4*)(cbv + 4); bias[0] = a[0]; bias[1] = a[1]; bias[2] = a[2]; bias[3] = a[3]; bias[4] = c[0]; bias[5] = c[1]; bias[6] = c[2]; bias[7] = c[3]; }
    const bf16* p = C.P() + (size_t)t0 * NP + ch;
#pragma unroll
    for (int e = 0; e < 8; ++e) { u1[e] = 0.f; u2[e] = 0.f; }
    if (sp0 >= 1) { const u32x4 hv = *(const u32x4*)(p - NP + C_AH), cv = *(const u32x4*)(p - NP + C_AC);
#pragma unroll
        for (int e2 = 0; e2 < 4; ++e2) { u1[2 * e2] = bflo(hv[e2]) * bflo(cv[e2]); u1[2 * e2 + 1] = bfhi(hv[e2]) * bfhi(cv[e2]); } }
    if (sp0 >= 2) { const u32x4 hv = *(const u32x4*)(p - 2 * (size_t)NP + C_AH), cv = *(const u32x4*)(p - 2 * (size_t)NP + C_AC);
#pragma unroll
        for (int e2 = 0; e2 < 4; ++e2) { u2[2 * e2] = bflo(hv[e2]) * bflo(cv[e2]); u2[2 * e2 + 1] = bfhi(hv[e2]) * bfhi(cv[e2]); } }
    bf16* yo = C.Y() + (size_t)t0 * YK + ch;
#pragma unroll 8
    for (int s = 0; s < 32; ++s) { const bf16* ps = p + (size_t)s * NP;
        const u32x4 hv = *(const u32x4*)(ps + C_AH), cv = *(const u32x4*)(ps + C_AC), bv = *(const u32x4*)(ps + C_AB), zv = *(const u32x4*)(ps + C_AZ); u32x4 o;
#pragma unroll
        for (int e2 = 0; e2 < 4; ++e2) { const float ul = bflo(hv[e2]) * bflo(cv[e2]), uh = bfhi(hv[e2]) * bfhi(cv[e2]);
            float yl = bias[2 * e2], yh = bias[2 * e2 + 1];
            yl += w[0][2 * e2] * u2[2 * e2]; yh += w[0][2 * e2 + 1] * u2[2 * e2 + 1];
            yl += w[1][2 * e2] * u1[2 * e2]; yh += w[1][2 * e2 + 1] * u1[2 * e2 + 1];
            yl += w[2][2 * e2] * ul; yh += w[2][2 * e2 + 1] * uh;
            u2[2 * e2] = u1[2 * e2]; u2[2 * e2 + 1] = u1[2 * e2 + 1]; u1[2 * e2] = ul; u1[2 * e2 + 1] = uh;
            o[e2] = cvt_pk_bf16(bflo(bv[e2]) * yl * siluf_(bflo(zv[e2])), bfhi(bv[e2]) * yh * siluf_(bfhi(zv[e2]))); }
        *(u32x4*)(yo + (size_t)s * YK) = o; }
}


#define GAS __attribute__((address_space(1)))
typedef float f32x4g __attribute__((ext_vector_type(4)));
__device__ __noinline__ void rstd_table(const GAS float* sp0, GAS float* rg, LAS float* rt) {
    const int t = threadIdx.x, row = t >> 1, half = t & 1; const GAS float* sp = sp0 + (size_t)row * 64 + half * 32; float s = 0.f;
#pragma unroll
    for (int k = 0; k < 8; ++k) { const f32x4 v = *(const GAS f32x4*)(sp + 4 * k); s += (v[0] + v[1]) + (v[2] + v[3]); }
    const float so = __shfl_xor(s, 1); const float tot = half ? (so + s) : (s + so); const float rs = 1.0f / sqrtf(tot * (1.0f / 4096.0f) + 1e-6f);
    if (half == 0) { rt[row] = rs; rg[row] = rs; }
}
constexpr int N_PHASES = 2 + 5 * NLAY + 1;
struct Args { const float* in[16]; float* out; unsigned char* ws; int ph_lo, ph_hi, li, pad; };
__global__ void __launch_bounds__(NWAVES * 64, 2) fwd(Args args) {
    extern __shared__ __attribute__((aligned(16))) unsigned char lds_raw[];
    LAS unsigned char* lds = (LAS unsigned char*)lds_raw;
    volatile LAS unsigned* MISC = (volatile LAS unsigned*)(lds + MISC_OFF);
    const int tid = tid_now();
    Ctx C;
    C.x = args.in[0]; C.mem = args.in[1]; C.norm_g = args.in[2]; C.w_in = args.in[3]; C.conv_w = args.in[4]; C.conv_b = args.in[5]; C.cmp_pos = args.in[6]; C.cmp_w1 = args.in[7];
    C.cmp_w2 = args.in[8]; C.mem_norm_g = args.in[9]; C.w_mem_kv = args.in[10]; C.w_up_a = args.in[11]; C.w_up_b = args.in[12]; C.w_up_x = args.in[13]; C.w_out = args.in[14]; C.final_g = args.in[15];
    C.out = args.out;
    unsigned char* ws = args.ws; C.ws = ws;
    C.G = gridDim.x; { const int bx = blockIdx.x; C.vcu = (C.G % 8 == 0) ? (bx % 8) * (C.G / 8) + bx / 8 : bx; }
    for (int u = tid; u < (LDS_BYTES - RING_BYTES) / 4; u += NWAVES * 64) ((LAS unsigned*)(lds + RING_BYTES))[u] = 0u;
    __syncthreads();
    const int lo = args.ph_lo, hi = args.ph_hi;
    const bool use_bar = (hi - lo) > 1;
    XcdBarrier bar; bar.bar = (unsigned*)(ws) + CW_BAR + args.li * XCD_BAR_WORDS; bar.x = 0; bar.st = MISC + 8;
    if (use_bar) bar = xcd_barrier_post((unsigned*)(ws) + CW_BAR + args.li * XCD_BAR_WORDS, MISC + 8);
#ifndef PHMASK
#define PHMASK 0xff
#endif
#define IN(k) (lo <= (k) && (k) < hi)
#define RELAUNDER() do { size_t z_ = 0; asm volatile("" : "+s"(z_)); C.ws = ws + z_; } while (0)
#define EN(b) ((PHMASK >> (b)) & 1)
#if defined(DOUBLE_BAR)
#define SEAM(k) do { if (IN(k) && IN((k) + 1)) { xcd_barrier(bar); xcd_barrier(bar); } } while (0)
#else
#define SEAM(k) do { if (IN(k) && IN((k) + 1)) xcd_barrier(bar); } while (0)
#endif

    if (EN(0) && IN(0)) { RELAUNDER(); p0_prologue(C, lds); __syncthreads(); }
    SEAM(0);
    if (EN(1) && IN(1)) { RELAUNDER();
        pg8::Gemm g{C.memb(), C.Wmkv_t(), NBAT * 256, 4096, DM}; pg8::StaticOrder S; S.init(NBAT * 256, 4096, C.G, bx_now());
        pg8::EpiProj E{C.MKV(), 4096, C.rstdm(), nullptr, nullptr, 0, 1 << 30};
        pg8::gemm_phase<pg8::EpiProj, pg8::StaticOrder, true, true>(lds, g, S, E);
        p0_tables(C);
        p0_convert(C, lds, (unsigned*)(ws) + CW_Q + 64 * args.li);
    }
    SEAM(1);
    for (int l = 0; l < NLAY; ++l) {
        const int pA = 2 + 5 * l;
        if (EN(2) && IN(pA)) { RELAUNDER();
            if (l == 0) { for (int it = blockIdx.x; it < 256; it += C.G) memvt_item(C, it, lds); }
            pg8::Gemm g{C.xb(), C.Win_t() + (size_t)l * NP * DM, TOK, NP, DM}; pg8::StaticOrder S; S.init(TOK, NP, C.G, bx_now());
            PG8_LAS float* rt = (PG8_LAS float*)(lds + RT_OFF); int pm0 = -1; { pg8::Unit u0; if (S.next(0, u0)) pm0 = u0.pm; }
            if (pm0 >= 0) rstd_table((const GAS float*)(C.ssqp() + (size_t)pm0 * 256 * 64), (GAS float*)(C.rstd() + pm0 * 256), rt);
            __syncthreads();
            pg8::EpiProj E{C.P(), NP, nullptr, rt, C.G8(), 3 * DM, C_MG / 256};
            pg8::gemm_phase<pg8::EpiProj, pg8::StaticOrder, true, true>(lds, g, S, E);
        }
        SEAM(pA);
        if (EN(3) && IN(pA + 1)) { RELAUNDER();
            for (int it = blockIdx.x; it < 128 + 128 + 256 + 256 + 256; it += C.G) {
                if (it < 128) { mem_unit(C, l, it >> 5, (it >> 3) & 3, it & 7, lds); }
                else if (it < 256) { conv_item(C, l, it - 128); }
                else if (it < 512) { cmp_item(C, l, it - 256, lds); }
                else if (it < 768) { ropevt_item(C, it - 512, lds); }
                else { gate_item(C, l, it - 768, lds); }
            }
        }
        SEAM(pA + 1);
        if (EN(4) && IN(pA + 2)) { RELAUNDER();
            for (int it = C.vcu; it < 256; it += C.G) { const int bg = it >> 4, pr = it & 15; nsa_unit(C, bg >> 2, bg & 3, 31 - pr, lds); nsa_unit(C, bg >> 2, bg & 3, pr, lds); }
        }
        SEAM(pA + 2);
        if (EN(5) && IN(pA + 3)) { RELAUNDER();
            pg8::Gemm g{C.Y(), C.Wup_t() + (size_t)l * DM * YK, TOK, DM, YK}; pg8::StaticOrder S; S.init(TOK, DM, C.G, bx_now());
            pg8::EpiUpF E{C.G8(), 3 * DM, DM, C.UB(), DM};
            pg8::gemm_phase<pg8::EpiUpF, pg8::StaticOrder, true, true>(lds, g, S, E);
        }
        SEAM(pA + 3);
        if (EN(6) && IN(pA + 4)) { RELAUNDER();
            pg8::Gemm g{C.UB(), C.Wo_t() + (size_t)l * DM * DM, TOK, DM, DM}; pg8::StaticOrder S; S.init(TOK, DM, C.G, bx_now());
            pg8::EpiOut E{C.xb(), C.ssqp(), DM};
            pg8::gemm_phase<pg8::EpiOut, pg8::StaticOrder, true, true>(lds, g, S, E);
        }
        SEAM(pA + 4);
    }
    if (EN(7) && IN(2 + 5 * NLAY)) { RELAUNDER(); final_phase(C); }
#undef IN
#undef EN
#undef SEAM
}


#ifndef N_LAUNCH_SPLIT
#define N_LAUNCH_SPLIT 0
#endif
extern "C" void kernel_launch(void* const* d_in, const int* in_sizes, int n_in, void* d_out, int out_size, void* d_ws, size_t ws_size, hipStream_t stream) {
    static int grid = 0;
    if (grid == 0) {
        if (n_in != 16 || out_size != TOK * DM || ws_size < WS_END) { fprintf(stderr, "kernel_launch: unexpected shapes (n_in %d, out %d, ws %zu < %zu)\n", n_in, out_size, ws_size, (size_t)WS_END); grid = -1; return; }
        int dev = 0, cus = 0;
        if (hipGetDevice(&dev) != hipSuccess || hipDeviceGetAttribute(&cus, hipDeviceAttributeMultiprocessorCount, dev) != hipSuccess) { grid = -1; return; }
        if (hipFuncSetAttribute((const void*)fwd, hipFuncAttributeMaxDynamicSharedMemorySize, LDS_BYTES) != hipSuccess) { fprintf(stderr, "kernel_launch: hipFuncSetAttribute failed\n"); grid = -1; return; }
        int per_cu = 0;
        if (hipOccupancyMaxActiveBlocksPerMultiprocessor(&per_cu, (const void*)fwd, NWAVES * 64, LDS_BYTES) != hipSuccess || per_cu < 1) fprintf(stderr, "kernel_launch: occupancy query says %d blocks per CU\n", per_cu);
        (void)hipGetLastError();
        grid = cus;
        { pg8::StaticOrder S; bool fixed = true;
          for (int c = 0; c < grid && fixed; ++c) { S.init(TOK, NP, grid, c); pg8::Unit u0, u; if (!S.next(0, u0)) continue; for (int i = 1; S.next(i, u); ++i) if (u.pm != u0.pm) { fixed = false; break; } }
          if (!fixed) { fprintf(stderr, "kernel_launch: unit order does not keep a workgroup inside one row panel at grid %d; nothing launched\n", grid); grid = -1; return; } }
    }
    if (grid < 0) return;
    (void)hipMemsetAsync(d_ws, 0, CTL_BYTES, stream);
    Args a{};
    for (int i = 0; i < 16; ++i) a.in[i] = (const float*)d_in[i];
    a.out = (float*)d_out; a.ws = (unsigned char*)d_ws;
#if N_LAUNCH_SPLIT
    for (int ph = 0; ph < N_PHASES; ++ph) { a.ph_lo = ph; a.ph_hi = ph + 1; hipLaunchKernelGGL(fwd, dim3(grid), dim3(NWAVES * 64), LDS_BYTES, stream, a);
    }
#elif defined(REPEAT_LO)
    a.ph_lo = 0; a.ph_hi = REPEAT_HI; a.li = 0; hipLaunchKernelGGL(fwd, dim3(grid), dim3(NWAVES * 64), LDS_BYTES, stream, a);
    a.ph_lo = REPEAT_LO; a.ph_hi = N_PHASES; a.li = 1; hipLaunchKernelGGL(fwd, dim3(grid), dim3(NWAVES * 64), LDS_BYTES, stream, a);
#elif defined(REPEAT_PH)
    a.ph_lo = 0; a.ph_hi = REPEAT_PH + 1; a.li = 0; hipLaunchKernelGGL(fwd, dim3(grid), dim3(NWAVES * 64), LDS_BYTES, stream, a);
    a.ph_lo = REPEAT_PH; a.ph_hi = N_PHASES; a.li = 1; hipLaunchKernelGGL(fwd, dim3(grid), dim3(NWAVES * 64), LDS_BYTES, stream, a);
#else
    a.ph_lo = 0; a.ph_hi = N_PHASES; hipLaunchKernelGGL(fwd, dim3(grid), dim3(NWAVES * 64), LDS_BYTES, stream, a);
#endif
}
```

```cpp
#include <hip/hip_runtime.h>
#include <cstdio>
#include <cstdint>
#include <cmath>
namespace pg8 {
#define PG8_LAS __attribute__((address_space(3)))
typedef unsigned short bf16_t;
typedef short bf16x8 __attribute__((ext_vector_type(8)));
typedef float f32x4 __attribute__((ext_vector_type(4)));
typedef unsigned u32x4 __attribute__((ext_vector_type(4)));
constexpr int BM = 256, BK = 64, HALF = 128, HTB = HALF * BK * 2  , STAGE_BYTES = 8 * HTB, NXCD = 8, WGM = 8;

__host__ __device__ __forceinline__ int lds_byte(int r, int c) { const int st = (r >> 4) * 2 + (c >> 5), rr = r & 15, cc = c & 31, ob = rr * 64 + cc * 2; return st * 1024 + (ob ^ (((ob >> 9) & 1) << 5)); }
__host__ __device__ __forceinline__ void stage_rc(int b, int& R, int& C) { const int st = b / 1024, sb = b % 1024, swz = sb ^ (((sb >> 9) & 1) << 5); R = (st >> 1) * 16 + swz / 64; C = (st & 1) * 32 + (swz % 64) / 2; }
__host__ __device__ __forceinline__ int perm32(int rho) { const int n = rho >> 4, i = rho & 15; return 8 * (i >> 2) + 4 * n + (i & 3); }

struct Unit { int pm, pn; };
struct Gemm { const bf16_t* A; const bf16_t* Bt; int M, N, K; };

struct StaticOrder {
    int nM, nN, nwg, G, c, mix;
    __host__ __device__ void init(int M, int N, int G_, int c_) { nM = M / BM; nN = N / BM; nwg = nM * nN; G = G_; c = c_; mix = 0; }
    __host__ __device__ __forceinline__ bool next(int i, Unit& u) const {
        const long L = (long)i * G + c; if (L >= nwg) return false;
        int wgid = (int)L; { const int q = nwg / NXCD, r = nwg % NXCD, xcd = wgid % NXCD, off = wgid / NXCD; wgid = (xcd < r ? xcd * (q + 1) : r * (q + 1) + (xcd - r) * q) + off; }
        const int nig = WGM * nN, gid = wgid / nig, fm = gid * WGM, gsz = (nM - fm) < WGM ? (nM - fm) : WGM;
        u.pm = fm + ((wgid % nig) % gsz); u.pn = (wgid % nig) / gsz;
        if (mix) { const int h = u.pn / 56, i = u.pn - 56 * h; u.pn = 28 * h + (i >> 1) + ((i & 1) ? 56 : 0); }
        return true;
    }
    __device__ __forceinline__ void a_ready(const Unit&) const {}
    __device__ __forceinline__ void done(const Unit&) const {}
};
typedef __bf16 bf16x2v __attribute__((ext_vector_type(2)));
typedef float f32x2v __attribute__((ext_vector_type(2)));
typedef unsigned u32x2 __attribute__((ext_vector_type(2)));
__device__ __forceinline__ unsigned cvt_pk_bf16(float lo, float hi) { f32x2v v = {lo, hi}; bf16x2v b = __builtin_convertvector(v, bf16x2v); return __builtin_bit_cast(unsigned, b); }
__device__ __forceinline__ float bflo(unsigned w) { return __uint_as_float(w << 16); }
__device__ __forceinline__ float bfhi(unsigned w) { return __uint_as_float(w & 0xffff0000u); }
__device__ __forceinline__ float sigmoidf_(float x) { return __builtin_amdgcn_rcpf(1.0f + __builtin_amdgcn_exp2f(-1.4426950408889634f * x)); }
__device__ __forceinline__ u32x4 pack8(const f32x4& v0, const f32x4& v1) { u32x4 w; w.x = cvt_pk_bf16(v0[0], v0[1]); w.y = cvt_pk_bf16(v0[2], v0[3]); w.z = cvt_pk_bf16(v1[0], v1[1]); w.w = cvt_pk_bf16(v1[2], v1[3]); return w; }

__device__ __forceinline__ unsigned q8_(float g) { return (unsigned)__builtin_fminf(g * 256.0f, 255.0f); }
__device__ __forceinline__ f32x2v gq2_(float a, float b) {
    const f32x2v x = {__builtin_amdgcn_fmed3f(a, -6.5f, 6.5f), __builtin_amdgcn_fmed3f(b, -6.5f, 6.5f)}; const f32x2v x2 = x * x;
    f32x2v p = x2 * (256.0f * 1.693533924e-10f) + (256.0f * -2.709654433e-08f);
    p = p * x2 + (256.0f * 1.777740446e-06f); p = p * x2 + (256.0f * -6.258466407e-05f); p = p * x2 + (256.0f * 1.324479733e-03f);
    p = p * x2 + (256.0f * -1.883604263e-02f); p = p * x2 + (256.0f * 2.483712057e-01f);
    const f32x2v y = p * x + 127.5f; return y + 12582912.0f;
}
__device__ __forceinline__ unsigned gpk4_(const f32x4& v) { const f32x2v a = gq2_(v[0], v[1]), b = gq2_(v[2], v[3]);
    return __builtin_amdgcn_perm(__float_as_uint(a.y), __float_as_uint(a.x), 0x0c0c0400u) | (__builtin_amdgcn_perm(__float_as_uint(b.y), __float_as_uint(b.x), 0x0c0c0400u) << 16); }
struct EpiProj {
    static constexpr bool PERM = true, AFTER_DRAIN = false, HAS_MID = false; static constexpr int MID0 = -1, MID1 = -1;
    bf16_t* O; int ldc; const float* rstd_g;
    PG8_LAS const float* rt;
    unsigned char* G8; int ldg, gate_pn0;
    __device__ __forceinline__ float row_scale(const Unit&, int row, int rloc) const { return rstd_g ? rstd_g[row] : rt[rloc]; }
    __device__ __forceinline__ void operator()(const f32x4 (&acc)[2][2][4][2], const Unit& u, int wr, int wc, int fr, int fq) const {
        const int rl0 = wr * 64 + fr, row0 = u.pm * BM + rl0;
        if (u.pn < gate_pn0) {
            const int col0 = u.pn * BM + wc * 32 + 8 * fq;
#pragma unroll
            for (int ai = 0; ai < 2; ++ai)
#pragma unroll
                for (int m = 0; m < 4; ++m) { const int row = row0 + ai * HALF + m * 16; const float rs = row_scale(u, row, rl0 + ai * HALF + m * 16); bf16_t* rowp = O + (size_t)row * ldc + col0;
#pragma unroll
                    for (int bj = 0; bj < 2; ++bj) { const f32x4 v0 = acc[ai][bj][m][0] * rs, v1 = acc[ai][bj][m][1] * rs; *(u32x4*)(rowp + bj * HALF) = pack8(v0, v1); } }
        } else {
            const int col0 = (u.pn - gate_pn0) * BM + wc * 32 + 8 * fq;
#pragma unroll
            for (int ai = 0; ai < 2; ++ai)
#pragma unroll
                for (int m = 0; m < 4; ++m) { const int row = row0 + ai * HALF + m * 16; const float rs = row_scale(u, row, rl0 + ai * HALF + m * 16); unsigned char* rowp = G8 + (size_t)row * ldg + col0;
#pragma unroll
                    for (int bj = 0; bj < 2; ++bj) { const f32x4 v0 = acc[ai][bj][m][0] * rs, v1 = acc[ai][bj][m][1] * rs; u32x2 w;
                        w.x = gpk4_(v0); w.y = gpk4_(v1);
                        *(u32x2*)(rowp + bj * HALF) = w; } }
        }
    }
};
__device__ __forceinline__ int perm16(int k) { return 8 * ((k >> 2) & 1) + 4 * (k >> 3) + (k & 3); }
__device__ __forceinline__ float ub_(unsigned w, int k) { return (float)((w >> (8 * k)) & 0xffu) + 0.5f; }
struct EpiUpF {
    static constexpr bool PERM = true, AFTER_DRAIN = false, HAS_MID = true; static constexpr int MID0 = 32, MID1 = 64;
    const unsigned char* G; int ldg, gstride; bf16_t* UB; int ldu;
    __device__ __forceinline__ void mid(f32x4 (&acc)[2][2][4][2], const Unit& u, bool second, int wr, int wc, int fr, int fq) const {
        const __amdgpu_buffer_rsrc_t rs = __builtin_amdgcn_make_buffer_rsrc((void*)G, 0, 0x7fffffff, 0x00020000);
        const int voff = (u.pm * BM + wr * 64 + fr) * ldg + u.pn * BM + wc * 32 + 8 * fq; const int sbase = second ? gstride : 0;
#pragma unroll
        for (int ai = 0; ai < 2; ++ai) {
            u32x2 ga[4][2], gb[4][2];
#pragma unroll
            for (int m = 0; m < 4; ++m)
#pragma unroll
                for (int bj = 0; bj < 2; ++bj) { const int so = sbase + (ai * HALF + m * 16) * ldg + bj * HALF;
                    ga[m][bj] = __builtin_amdgcn_raw_buffer_load_b64(rs, voff, so, 0); gb[m][bj] = __builtin_amdgcn_raw_buffer_load_b64(rs, voff, so + gstride, 0); }
#pragma unroll
            for (int m = 0; m < 4; ++m)
#pragma unroll
                for (int bj = 0; bj < 2; ++bj) { const u32x2 a = ga[m][bj], b = gb[m][bj];
                    const f32x4 r0 = {ub_(a.x, 0) * __builtin_amdgcn_rcpf(ub_(b.x, 0)), ub_(a.x, 1) * __builtin_amdgcn_rcpf(ub_(b.x, 1)), ub_(a.x, 2) * __builtin_amdgcn_rcpf(ub_(b.x, 2)), ub_(a.x, 3) * __builtin_amdgcn_rcpf(ub_(b.x, 3))};
                    acc[ai][bj][m][0] = acc[ai][bj][m][0] * r0;
                    const f32x4 r1 = {ub_(a.y, 0) * __builtin_amdgcn_rcpf(ub_(b.y, 0)), ub_(a.y, 1) * __builtin_amdgcn_rcpf(ub_(b.y, 1)), ub_(a.y, 2) * __builtin_amdgcn_rcpf(ub_(b.y, 2)), ub_(a.y, 3) * __builtin_amdgcn_rcpf(ub_(b.y, 3))};
                    acc[ai][bj][m][1] = acc[ai][bj][m][1] * r1; }
            asm volatile("" ::: "memory"); }
    }
    __device__ __forceinline__ void operator()(const f32x4 (&acc)[2][2][4][2], const Unit& u, int wr, int wc, int fr, int fq) const {
        const __amdgpu_buffer_rsrc_t rs = __builtin_amdgcn_make_buffer_rsrc((void*)G, 0, 0x7fffffff, 0x00020000);
        const int row0 = u.pm * BM + wr * 64 + fr, col0 = u.pn * BM + wc * 32 + 8 * fq; const int voff = row0 * ldg + col0;
#pragma unroll
        for (int ai = 0; ai < 2; ++ai) {
            u32x2 gwv[4][2];
#pragma unroll
            for (int m = 0; m < 4; ++m)
#pragma unroll
                for (int bj = 0; bj < 2; ++bj) gwv[m][bj] = __builtin_amdgcn_raw_buffer_load_b64(rs, voff, 2 * gstride + (ai * HALF + m * 16) * ldg + bj * HALF, 0);
#pragma unroll
            for (int m = 0; m < 4; ++m) { const int row = row0 + ai * HALF + m * 16;
#pragma unroll
                for (int bj = 0; bj < 2; ++bj) { const int col = col0 + bj * HALF; const u32x2 gw = gwv[m][bj]; const float k = 1.0f / 256.0f;
                    const f32x4 g0 = {ub_(gw.x, 0) * k, ub_(gw.x, 1) * k, ub_(gw.x, 2) * k, ub_(gw.x, 3) * k}, g1 = {ub_(gw.y, 0) * k, ub_(gw.y, 1) * k, ub_(gw.y, 2) * k, ub_(gw.y, 3) * k};
                    *(u32x4*)(UB + (size_t)row * ldu + col) = pack8(acc[ai][bj][m][0] * g0, acc[ai][bj][m][1] * g1); } }
            asm volatile("" ::: "memory"); }
    }
};
struct EpiOut {
    static constexpr bool PERM = true, AFTER_DRAIN = false, HAS_MID = false; static constexpr int MID0 = -1, MID1 = -1;
    bf16_t* xb; float* ssqp; int ldc;
    __device__ __forceinline__ void operator()(const f32x4 (&acc)[2][2][4][2], const Unit& u, int wr, int wc, int fr, int fq) const {
        const int row0 = u.pm * BM + wr * 64 + fr, col0 = u.pn * BM + wc * 32 + 8 * fq;
#pragma unroll
        for (int ai = 0; ai < 2; ++ai)
#pragma unroll
            for (int m = 0; m < 4; ++m) { const int row = row0 + ai * HALF + m * 16; float ss = 0.f;
#pragma unroll
                for (int bj = 0; bj < 2; ++bj) { const size_t off = (size_t)row * ldc + col0 + bj * HALF; const u32x4 xo = *(const u32x4*)(xb + off);
                    const f32x4 v0 = (f32x4){bflo(xo.x), bfhi(xo.x), bflo(xo.y), bfhi(xo.y)} + acc[ai][bj][m][0], v1 = (f32x4){bflo(xo.z), bfhi(xo.z), bflo(xo.w), bfhi(xo.w)} + acc[ai][bj][m][1];
                    *(u32x4*)(xb + off) = pack8(v0, v1);
                    ss += (v0[0] * v0[0] + v0[1] * v0[1]) + (v0[2] * v0[2] + v0[3] * v0[3]) + (v1[0] * v1[0] + v1[1] * v1[1]) + (v1[2] * v1[2] + v1[3] * v1[3]); }
                ss += __shfl_xor(ss, 16); ss += __shfl_xor(ss, 32);
                if (fq == 0) ssqp[(size_t)row * 64 + u.pn * 4 + wc] = ss; }
    }
};

template <class Epi, class Sched, bool ALIGN_EPI = false, bool SP2 = false>
__device__ __forceinline__ void gemm_phase(PG8_LAS unsigned char* lds, const Gemm g, const Sched& S, const Epi& E) {
    int tid = threadIdx.x; asm volatile("" : "+v"(tid)); const int wid = __builtin_amdgcn_readfirstlane(tid >> 6), lane = tid & 63, wr = wid >> 2, wc = wid & 3, fr = lane & 15, fq = lane >> 4;
    const int K = g.K, nt = K / BK;
    unsigned voffA[2], voffB[2];
#pragma unroll
    for (int i = 0; i < 2; ++i) { int R, C; stage_rc(tid * 16 + i * 8192, R, C); const int Rb = Epi::PERM ? ((R & ~31) + perm32(R & 31)) : R;
        voffA[i] = (unsigned)(R * K + C) * 2u; voffB[i] = (unsigned)(Rb * K + C) * 2u; }
    const size_t kstep = (size_t)(BK * 2);
    const size_t hstep = (size_t)HALF * K * 2;
    const size_t tstep = 2 * hstep;
    const unsigned ldsw = (unsigned)wid * 1024u;
    const int aoff = lds_byte(wr * 64 + fr, fq * 8), boff = lds_byte(wc * 32 + fr, fq * 8);
#define PG8_SA(b, h) (((b) * 2 + (h)) * HTB)
#define PG8_SB(b, h) ((4 + (b) * 2 + (h)) * HTB)
#define PG8_STAGE(bufoff, gbase, voff) do { _Pragma("unroll") for (int _i = 0; _i < 2; ++_i) \
        __builtin_amdgcn_global_load_lds((const unsigned*)((const char*)(gbase) + (voff)[_i]), (PG8_LAS unsigned*)(lds + (bufoff) + ldsw + _i * 8192), 16, 0, PG8_AAUX); } while (0)
#ifndef PG8_BAUX
#define PG8_BAUX 0
#endif
#ifndef PG8_AAUX
#define PG8_AAUX 0
#endif
#define PG8_STAGEB(bufoff, gbase, voff) do { _Pragma("unroll") for (int _i = 0; _i < 2; ++_i) \
        __builtin_amdgcn_global_load_lds((const unsigned*)((const char*)(gbase) + (voff)[_i]), (PG8_LAS unsigned*)(lds + (bufoff) + ldsw + _i * 8192), 16, 0, PG8_BAUX); } while (0)
#define PG8_LDA(dst, b, h) do { _Pragma("unroll") for (int m = 0; m < 4; ++m) _Pragma("unroll") for (int k = 0; k < 2; ++k) dst[m][k] = *(const PG8_LAS bf16x8*)(lds + PG8_SA(b, h) + aoff + m * 2048 + k * 1024); } while (0)
#define PG8_LDB(dst, b, h) do { _Pragma("unroll") for (int n = 0; n < 2; ++n) _Pragma("unroll") for (int k = 0; k < 2; ++k) dst[n][k] = *(const PG8_LAS bf16x8*)(lds + PG8_SB(b, h) + boff + n * 2048 + k * 1024); } while (0)
#define PG8_MMA(ai, bj, At, Bt) do { __builtin_amdgcn_s_setprio(1); _Pragma("unroll") for (int m = 0; m < 4; ++m) _Pragma("unroll") for (int n = 0; n < 2; ++n) _Pragma("unroll") for (int k = 0; k < 2; ++k) \
        acc[ai][bj][m][n] = __builtin_amdgcn_mfma_f32_16x16x32_bf16(Bt[n][k], At[m][k], acc[ai][bj][m][n], 0, 0, 0); __builtin_amdgcn_s_setprio(0); } while (0)
#define PG8_WAIT_V(n) asm volatile("s_waitcnt vmcnt(" #n ")" ::: "memory")
#define PG8_WAIT_L(n) asm volatile("s_waitcnt lgkmcnt(" #n ")" ::: "memory")
#define PG8_BAR __builtin_amdgcn_s_barrier()
#define PG8_SCHED __builtin_amdgcn_sched_barrier(0)
    Unit cur, nxt; int ui = 0;
    if (!S.next(0, cur)) return;
    f32x4 acc[2][2][4][2];
#pragma unroll
    for (int a = 0; a < 2; ++a)
#pragma unroll
        for (int b = 0; b < 2; ++b)
#pragma unroll
            for (int m = 0; m < 4; ++m)
#pragma unroll
                for (int n = 0; n < 2; ++n) acc[a][b][m][n] = (f32x4){0.f, 0.f, 0.f, 0.f};
    bf16x8 At[4][2], B0[2][2], B1[2][2];
    const char* cA = (const char*)g.A + (size_t)cur.pm * tstep; const char* cB = (const char*)g.Bt + (size_t)cur.pn * tstep;
    S.a_ready(cur);
    if constexpr (SP2) {
        PG8_STAGEB(PG8_SB(0, 0), cB, voffB); PG8_STAGEB(PG8_SB(0, 1), cB + hstep, voffB); PG8_STAGE(PG8_SA(0, 0), cA, voffA); PG8_STAGE(PG8_SA(0, 1), cA + hstep, voffA);
        if (wr == 1) PG8_BAR;
        PG8_WAIT_V(2); PG8_BAR;
        PG8_STAGEB(PG8_SB(1, 0), cB + kstep, voffB); PG8_STAGE(PG8_SA(1, 0), cA + kstep, voffA); PG8_STAGEB(PG8_SB(1, 1), cB + hstep + kstep, voffB);
        PG8_WAIT_V(6); PG8_BAR;
    } else {
        PG8_STAGEB(PG8_SB(0, 0), cB, voffB); PG8_STAGE(PG8_SA(0, 0), cA, voffA); PG8_STAGEB(PG8_SB(0, 1), cB + hstep, voffB); PG8_STAGE(PG8_SA(0, 1), cA + hstep, voffA);
        if (wr == 1) PG8_BAR;
        PG8_WAIT_V(4); PG8_BAR;
        PG8_STAGEB(PG8_SB(1, 0), cB + kstep, voffB); PG8_STAGE(PG8_SA(1, 0), cA + kstep, voffA); PG8_STAGEB(PG8_SB(1, 1), cB + hstep + kstep, voffB);
        PG8_WAIT_V(6); PG8_BAR;
    }
    for (;;) {
        const bool has_next = S.next(ui + 1, nxt);
        const char* nA = has_next ? (const char*)g.A + (size_t)nxt.pm * tstep : cA; const char* nB = has_next ? (const char*)g.Bt + (size_t)nxt.pn * tstep : cB;
        for (int t = 0; t < nt; t += 2) {
            const bool last = (t == nt - 2);
            const char* a1 = cA + (size_t)(t + 1) * kstep;
            const char* a2 = last ? nA : cA + (size_t)(t + 2) * kstep; const char* b2 = last ? nB : cB + (size_t)(t + 2) * kstep;
            const char* a3 = a2 + kstep; const char* b3 = b2 + kstep;
            if (last && has_next) S.a_ready(nxt);
            if constexpr (Epi::HAS_MID) { if (t == Epi::MID0 || t == Epi::MID1) E.mid(acc, cur, t == Epi::MID1, wr, wc, fr, fq); }
            if constexpr (SP2) {
            PG8_LDB(B0, 0, 0); PG8_LDB(B1, 0, 1); PG8_SCHED; PG8_LDA(At, 0, 0); PG8_STAGE(PG8_SA(1, 1), a1 + hstep, voffA);
            PG8_WAIT_V(8); PG8_WAIT_L(0); PG8_BAR; PG8_MMA(0, 0, At, B0); PG8_MMA(0, 1, At, B1); PG8_BAR; PG8_SCHED;
            PG8_LDA(At, 0, 1); PG8_STAGEB(PG8_SB(0, 0), b2, voffB); PG8_STAGEB(PG8_SB(0, 1), b2 + hstep, voffB); PG8_STAGE(PG8_SA(0, 0), a2, voffA);
            PG8_WAIT_V(8); PG8_WAIT_L(0); PG8_BAR; PG8_MMA(1, 0, At, B0); PG8_MMA(1, 1, At, B1); PG8_BAR; PG8_SCHED;
            PG8_LDB(B0, 1, 0); PG8_LDB(B1, 1, 1); PG8_SCHED; PG8_LDA(At, 1, 0); PG8_STAGE(PG8_SA(0, 1), a2 + hstep, voffA);
            PG8_WAIT_V(8); PG8_WAIT_L(0); PG8_BAR; PG8_MMA(0, 0, At, B0); PG8_MMA(0, 1, At, B1); PG8_BAR; PG8_SCHED;
            PG8_LDA(At, 1, 1); PG8_STAGEB(PG8_SB(1, 0), b3, voffB); PG8_STAGEB(PG8_SB(1, 1), b3 + hstep, voffB); PG8_STAGE(PG8_SA(1, 0), a3, voffA);
            PG8_WAIT_V(8); PG8_WAIT_L(0); PG8_BAR; PG8_MMA(1, 0, At, B0); PG8_MMA(1, 1, At, B1); PG8_BAR; PG8_SCHED;
            } else {
            PG8_LDB(B0, 0, 0); PG8_SCHED; PG8_LDA(At, 0, 0); PG8_STAGE(PG8_SA(1, 1), a1 + hstep, voffA);
            PG8_WAIT_L(8); PG8_BAR; PG8_WAIT_L(0); PG8_MMA(0, 0, At, B0); PG8_BAR; PG8_SCHED;
            PG8_LDB(B1, 0, 1); PG8_STAGEB(PG8_SB(0, 0), b2, voffB);
            PG8_BAR; PG8_WAIT_L(0); PG8_MMA(0, 1, At, B1); PG8_BAR;
            PG8_LDA(At, 0, 1); PG8_STAGE(PG8_SA(0, 0), a2, voffA);
            PG8_BAR; PG8_WAIT_L(0); PG8_MMA(1, 0, At, B0); PG8_BAR; PG8_SCHED;
            PG8_STAGEB(PG8_SB(0, 1), b2 + hstep, voffB);
            PG8_WAIT_V(6); PG8_BAR; PG8_MMA(1, 1, At, B1); PG8_BAR;
            PG8_LDB(B0, 1, 0); PG8_SCHED; PG8_LDA(At, 1, 0); PG8_STAGE(PG8_SA(0, 1), a2 + hstep, voffA);
            PG8_WAIT_L(8); PG8_BAR; PG8_WAIT_L(0); PG8_MMA(0, 0, At, B0); PG8_BAR; PG8_SCHED;
            PG8_LDB(B1, 1, 1); PG8_STAGEB(PG8_SB(1, 0), b3, voffB);
            PG8_BAR; PG8_WAIT_L(0); PG8_MMA(0, 1, At, B1); PG8_BAR;
            PG8_LDA(At, 1, 1); PG8_STAGE(PG8_SA(1, 0), a3, voffA);
            PG8_BAR; PG8_WAIT_L(0); PG8_MMA(1, 0, At, B0); PG8_BAR; PG8_SCHED;
            PG8_STAGEB(PG8_SB(1, 1), b3 + hstep, voffB);
            PG8_WAIT_V(6); PG8_BAR; PG8_MMA(1, 1, At, B1); PG8_BAR;
            }
        }
        if constexpr (ALIGN_EPI) { if (wr == 0) PG8_BAR; }
        if constexpr (!Epi::AFTER_DRAIN) { E(acc, cur, wr, wc, fr, fq); S.done(cur); }
        if (!has_next) break;
#pragma unroll
        for (int a = 0; a < 2; ++a)
#pragma unroll
            for (int b = 0; b < 2; ++b)
#pragma unroll
                for (int m = 0; m < 4; ++m)
#pragma unroll
                    for (int n = 0; n < 2; ++n) acc[a][b][m][n] = (f32x4){0.f, 0.f, 0.f, 0.f};
        cur = nxt; cA = nA; cB = nB; ++ui;
        if constexpr (ALIGN_EPI) { if (wr == 1) PG8_BAR; }
    }
    PG8_WAIT_V(0);
    if constexpr (!ALIGN_EPI) { if (wr == 0) PG8_BAR; }
    PG8_BAR;
    if constexpr (Epi::AFTER_DRAIN) { E.fused(acc, cur, wr, wc, fr, fq, lds, wid, lane); S.done(cur); }
#undef PG8_SA
#undef PG8_SB
#undef PG8_STAGE
#undef PG8_STAGEB
#undef PG8_LDA
#undef PG8_LDB
#undef PG8_MMA
#undef PG8_WAIT_V
#undef PG8_WAIT_L
#undef PG8_BAR
#undef PG8_SCHED
}
}

#define LAS __attribute__((address_space(3)))
typedef unsigned short bf16;
typedef short bf16x8 __attribute__((ext_vector_type(8)));
typedef float f32x4 __attribute__((ext_vector_type(4)));
typedef float f32x16 __attribute__((ext_vector_type(16)));
typedef unsigned u32x4 __attribute__((ext_vector_type(4)));
typedef unsigned u32x2 __attribute__((ext_vector_type(2)));
using pg8::cvt_pk_bf16; using pg8::bflo; using pg8::bfhi; using pg8::sigmoidf_; using pg8::perm16;

constexpr int DM = 4096, NBAT = 4, SEQ = 2048, NLAY = 4, TOK = NBAT * SEQ, HD = 128;
constexpr int NP = 28672;
constexpr int C_AH = 0, C_AB = 2048, C_AC = 4096, C_AZ = 6144, C_NQ = 8192, C_KV = 10240, C_NZ = 13312, C_XQ = 15360, C_XZ = 15872, C_MG = 16384;
constexpr int INW = 28720, S_NG = 13312, S_NZ = 13360;
constexpr float EPS = 1e-6f;
constexpr int NWAVES = 8;

constexpr size_t CTL_BYTES = 1u << 20;
constexpr size_t WS_WIN = CTL_BYTES;
constexpr int YK = 4608;
constexpr size_t WS_WUP = WS_WIN + (size_t)NLAY * NP * DM * 2;
constexpr size_t WS_WO = WS_WUP + (size_t)NLAY * DM * YK * 2;
constexpr size_t WS_WMKV = WS_WO + (size_t)NLAY * DM * DM * 2;
constexpr size_t WS_W1 = WS_WMKV + (size_t)4096 * DM * 2;
constexpr size_t WS_W2 = WS_W1 + (size_t)NLAY * 2 * 128 * 4096 * 2;
constexpr size_t WS_PB = WS_W2 + (size_t)NLAY * 2 * 128 * 128 * 2;
constexpr size_t WS_COS = WS_PB + 4096;
constexpr size_t WS_SIN = WS_COS + (size_t)SEQ * 64 * 4;
constexpr size_t WS_XB = WS_SIN + (size_t)SEQ * 64 * 4;
constexpr size_t WS_MEMB = WS_XB + (size_t)TOK * DM * 2;
constexpr size_t WS_RSTDM = WS_MEMB + (size_t)1024 * DM * 2;
constexpr size_t WS_SSQP = WS_RSTDM + 4096;
constexpr size_t WS_RSTD = WS_SSQP + (size_t)TOK * 64 * 4;
constexpr size_t WS_P = WS_RSTD + (size_t)TOK * 4;
constexpr size_t WS_MEMK = WS_P + (size_t)TOK * NP * 2;
constexpr size_t WS_MEMVT = WS_MEMK + (size_t)1024 * 4096 * 2;
constexpr size_t WS_KR = WS_MEMVT + (size_t)NLAY * 16 * 256 * 128 * 2;
constexpr size_t WS_VT = WS_KR + (size_t)2 * 16 * SEQ * 128 * 2;
constexpr size_t WS_KC = WS_VT + (size_t)2 * 16 * SEQ * 128 * 2;
constexpr size_t WS_VTC = WS_KC + (size_t)16 * 128 * 128 * 2;
constexpr size_t WS_Y = WS_VTC + (size_t)16 * 128 * 128 * 2;
constexpr size_t WS_UB = WS_Y + (size_t)TOK * YK * 2;
constexpr size_t WS_MEMK2 = WS_UB + (size_t)TOK * DM * 2;
constexpr size_t WS_WG = WS_MEMK2 + (size_t)NLAY * 16 * 256 * 128 * 2;
constexpr size_t WS_NG = WS_WG + (size_t)NLAY * 64 * DM * 2;
constexpr size_t WS_TSC = WS_NG + (size_t)TOK * 48 * 4;
constexpr size_t WS_G8 = WS_TSC + (size_t)320 * 8 * 32 * 64 * 4;
constexpr size_t WS_END = WS_G8 + (size_t)TOK * 3 * DM;
constexpr int CW_Q = 12288;
constexpr int CW_BAR = 4096;

constexpr int RING_BYTES = 131072, MISC_OFF = RING_BYTES + 320, RT_OFF = RING_BYTES + 2048  , LDS_BYTES = 147456;
constexpr int A_KB0 = 0, A_KB1 = 16384, A_VB0 = 32768, A_VB1 = 49152, A_IMPW = 65536;
constexpr int A_IMPS = A_IMPW + 8 * 32 * 33 * 4, A_SELM = A_IMPS + 64 * 33 * 4, A_END = A_SELM + 256;
static_assert(A_END <= RING_BYTES, "attention LDS map");

#define LDS_WAIT() asm volatile("s_waitcnt lgkmcnt(0)" ::: "memory")
__device__ __forceinline__ int bx_now() { int b = blockIdx.x; asm volatile("" : "+s"(b)); return b; }
__device__ __forceinline__ int tid_now() { int t = threadIdx.x; asm volatile("" : "+v"(t)); return t; }
__device__ __forceinline__ float bf2f(bf16 v) { return __uint_as_float(((unsigned)v) << 16); }
__device__ __forceinline__ bf16 f2bf(float f) { return (bf16)(cvt_pk_bf16(f, 0.f) & 0xffffu); }
__device__ __forceinline__ float wave_sum(float v) {
#pragma unroll
    for (int o = 1; o < 64; o <<= 1) v += __shfl_xor(v, o);
    return v;
}
__device__ __forceinline__ float siluf_(float x) { return x * sigmoidf_(x); }

#define XB_TMO      128
#define XB_XCNT(j)  (256  + 64 * (j))
#define XB_XSUB(j)  (1280 + 64 * (j))
#define XB_XGEN(j)  (2304 + 64 * (j))
#define XB_TOP      3328
#define XB_TOPGEN   3392
#define XCD_BAR_WORDS 3456
#define XB_SPIN_CAP (1u << 22)
__device__ __forceinline__ unsigned xb_ld(unsigned* p)              { return __hip_atomic_load(p, __ATOMIC_RELAXED, __HIP_MEMORY_SCOPE_AGENT); }
__device__ __forceinline__ unsigned xb_add(unsigned* p, unsigned v) { return __hip_atomic_fetch_add(p, v, __ATOMIC_RELAXED, __HIP_MEMORY_SCOPE_AGENT); }
__device__ __forceinline__ unsigned xb_xcc_id() { return (unsigned)__builtin_amdgcn_s_getreg((3 << 11) | 20) & 0xFu; }
#define XB_SPIN(cond, bar) do { unsigned _sp = 0; while (cond) { __builtin_amdgcn_s_sleep(1); \
    if ((++_sp & 255u) == 0u) { if (xb_ld(&(bar)[XB_TMO])) break; if (_sp > XB_SPIN_CAP) { atomicAdd(&(bar)[XB_TMO], 1u); break; } } } } while (0)
struct XcdBarrier { unsigned* bar; unsigned x; volatile LAS unsigned* st; };
__device__ __forceinline__ XcdBarrier xcd_barrier_post(unsigned* bar, volatile LAS unsigned* st) {
    XcdBarrier b; b.bar = bar; b.x = xb_xcc_id(); b.st = st;
    if (threadIdx.x == 0) (void)xb_add(&bar[XB_XCNT(b.x)], 1u);
    return b;
}
__device__ __forceinline__ void xcd_barrier_complete(unsigned* bar, unsigned x, unsigned& nloc, unsigned& nx) {
    const unsigned G = gridDim.x * gridDim.y * gridDim.z;
    unsigned sum, cnt, mine, sp = 0u;
    for (;;) {
        sum = 0u; cnt = 0u; mine = 0u;
#pragma unroll
        for (unsigned j = 0; j < 16; ++j) { const unsigned c = xb_ld(&bar[XB_XCNT(j)]); sum += c; cnt += (c > 0u) ? 1u : 0u; mine = (j == x) ? c : mine; }
        if (sum == G) break;
        __builtin_amdgcn_s_sleep(1);
        if ((++sp & 255u) == 0u) { if (xb_ld(&bar[XB_TMO])) break; if (sp > XB_SPIN_CAP) { atomicAdd(&bar[XB_TMO], 1u); break; } }
    }
    nloc = mine > 0u ? mine : 1u; nx = cnt > 0u ? cnt : 1u;
}
__device__ __forceinline__ void xcd_barrier(const XcdBarrier& b) {
    asm volatile("s_waitcnt vmcnt(0)" ::: "memory");
    __syncthreads();
    if (threadIdx.x == 0) {
        unsigned* bar = b.bar;
        __builtin_amdgcn_s_waitcnt(0);
        unsigned nloc = b.st[0], nx = b.st[1];
        if (nloc == 0u) { xcd_barrier_complete(bar, b.x, nloc, nx); b.st[0] = nloc; b.st[1] = nx; }
        const unsigned old = xb_add(&bar[XB_XSUB(b.x)], 1u);
        const unsigned gen = old / nloc;
        if (old + 1u == (gen + 1u) * nloc) {
            __builtin_amdgcn_fence(__ATOMIC_RELEASE, "agent");
            asm volatile("s_waitcnt vmcnt(0)" ::: "memory");
            const unsigned og = xb_add(&bar[XB_TOP], 1u);
            const unsigned tg = og / nx;
            if (og + 1u == (tg + 1u) * nx) xb_add(&bar[XB_TOPGEN], 1u);
            else XB_SPIN(xb_ld(&bar[XB_TOPGEN]) == tg, bar);
            __builtin_amdgcn_fence(__ATOMIC_ACQUIRE, "agent");
            xb_add(&bar[XB_XGEN(b.x)], 1u);
            asm volatile("s_waitcnt vmcnt(0)" ::: "memory");
        } else {
            XB_SPIN(xb_ld(&bar[XB_XGEN(b.x)]) == gen, bar);
            __builtin_amdgcn_fence(__ATOMIC_ACQUIRE, "agent");
            asm volatile("s_waitcnt vmcnt(0)" ::: "memory");
        }
    }
    __syncthreads();
}

struct Ctx {
    const float *x, *mem, *norm_g, *w_in, *conv_w, *conv_b, *cmp_pos, *cmp_w1, *cmp_w2, *mem_norm_g, *w_mem_kv, *w_up_a, *w_up_b, *w_up_x, *w_out, *final_g;
    float* out;
    unsigned char* ws;
    int G, vcu;
    __device__ __forceinline__ bf16* Win_t() const { return (bf16*)(ws + WS_WIN); }
    __device__ __forceinline__ bf16* Wup_t() const { return (bf16*)(ws + WS_WUP); }
    __device__ __forceinline__ bf16* Wo_t() const { return (bf16*)(ws + WS_WO); }
    __device__ __forceinline__ bf16* Wmkv_t() const { return (bf16*)(ws + WS_WMKV); }
    __device__ __forceinline__ bf16* W1_t() const { return (bf16*)(ws + WS_W1); }
    __device__ __forceinline__ bf16* W2_t() const { return (bf16*)(ws + WS_W2); }
    __device__ __forceinline__ float* pb() const { return (float*)(ws + WS_PB); }
    __device__ __forceinline__ float* cost() const { return (float*)(ws + WS_COS); }
    __device__ __forceinline__ float* sint() const { return (float*)(ws + WS_SIN); }
    __device__ __forceinline__ float* rstdm() const { return (float*)(ws + WS_RSTDM); }
    __device__ __forceinline__ float* ssqp() const { return (float*)(ws + WS_SSQP); }
    __device__ __forceinline__ float* rstd() const { return (float*)(ws + WS_RSTD); }
    __device__ __forceinline__ bf16* xb() const { return (bf16*)(ws + WS_XB); }
    __device__ __forceinline__ bf16* memb() const { return (bf16*)(ws + WS_MEMB); }
    __device__ __forceinline__ bf16* P() const { return (bf16*)(ws + WS_P); }
    __device__ __forceinline__ bf16* MKV() const { return (bf16*)(ws + WS_MEMK); }
    __device__ __forceinline__ bf16* memK() const { return (bf16*)(ws + WS_MEMK2); }
    __device__ __forceinline__ bf16* memVt() const { return (bf16*)(ws + WS_MEMVT); }
    __device__ __forceinline__ bf16* Kr() const { return (bf16*)(ws + WS_KR); }
    __device__ __forceinline__ bf16* Vt() const { return (bf16*)(ws + WS_VT); }
    __device__ __forceinline__ bf16* Kc() const { return (bf16*)(ws + WS_KC); }
    __device__ __forceinline__ bf16* Vtc() const { return (bf16*)(ws + WS_VTC); }
    __device__ __forceinline__ bf16* Y() const { return (bf16*)(ws + WS_Y); }
    __device__ __forceinline__ bf16* UB() const { return (bf16*)(ws + WS_UB); }
    __device__ __forceinline__ unsigned* tsc() const { return (unsigned*)(ws + WS_TSC); }
    __device__ __forceinline__ bf16* Wg_t() const { return (bf16*)(ws + WS_WG); }
    __device__ __forceinline__ float* ng() const { return (float*)(ws + WS_NG); }
    __device__ __forceinline__ unsigned char* G8() const { return ws + WS_G8; }
};

struct TrJob { const float* W; const float* gs; bf16* WT; int ldw, k0, ns, nvalid, ldk, nd; };
struct TrRegs { f32x4 v[8]; f32x4 g0, g1; };
__device__ __forceinline__ void tr_load(TrRegs& R, const TrJob& j, int lane) {
    const int col4 = (lane & 7) * 4, r0 = lane >> 3;
#pragma unroll
    for (int i = 0; i < 8; ++i) { f32x4 v = {0.f, 0.f, 0.f, 0.f}; if (col4 < j.nvalid) v = *(const f32x4*)(j.W + (size_t)(j.k0 + 8 * i + r0) * j.ldw + j.ns + col4); R.v[i] = v; }
    R.g0 = (f32x4){1.f, 1.f, 1.f, 1.f}; R.g1 = R.g0;
    if (j.gs) { R.g0 = *(const f32x4*)(j.gs + j.k0 + 8 * (lane & 7)); R.g1 = *(const f32x4*)(j.gs + j.k0 + 8 * (lane & 7) + 4); }
}
__device__ __forceinline__ void tr_store(const TrRegs& R, const TrJob& j, LAS float* scr, int lane) {
    const int col4 = (lane & 7) * 4, r0 = lane >> 3;
#pragma unroll
    for (int i = 0; i < 8; ++i) { LAS float* d = scr + (8 * i + r0) * 33 + col4; d[0] = R.v[i][0]; d[1] = R.v[i][1]; d[2] = R.v[i][2]; d[3] = R.v[i][3]; }
    LDS_WAIT();
    const int c = lane & 7;
#pragma unroll
    for (int jj = 0; jj < 4; ++jj) { const int n = (lane >> 3) + 8 * jj; const LAS float* s = scr + (8 * c) * 33 + n;
        u32x4 o; o.x = cvt_pk_bf16(s[0 * 33] * R.g0[0], s[1 * 33] * R.g0[1]); o.y = cvt_pk_bf16(s[2 * 33] * R.g0[2], s[3 * 33] * R.g0[3]); o.z = cvt_pk_bf16(s[4 * 33] * R.g1[0], s[5 * 33] * R.g1[1]); o.w = cvt_pk_bf16(s[6 * 33] * R.g1[2], s[7 * 33] * R.g1[3]);
        *(u32x4*)(j.WT + (size_t)(j.nd + n) * j.ldk + j.k0 + 8 * c) = o; }
    LDS_WAIT();
}
constexpr int IT_IN1 = 64 * 416, IT_IN2 = 64 * 480, IT_ING = 64 * 2, IT_UA = 32 * 128, IT_UX = 8 * 128, IT_O = 64 * 128, IT_MKV = 64 * 32, IT_W1 = 64 * 4, IT_W2 = 2 * 4;
constexpr int IT_LAYER = IT_IN1 + IT_IN2 + IT_ING + 2 * IT_UA + IT_UX + IT_O + 2 * IT_W1 + 2 * IT_W2;
constexpr int TR_ITEMS = NLAY * IT_LAYER, TRCH = 16;
__device__ __forceinline__ TrJob tr_decode(const Ctx& C, int it) {
    TrJob j; const int l = it / IT_LAYER; int r = it - l * IT_LAYER; j.gs = nullptr; j.nvalid = 32;
    if (r < IT_IN1 + IT_IN2 + IT_ING) { j.W = C.w_in + (size_t)l * DM * INW; j.ldw = INW; j.gs = C.norm_g + l * DM; j.WT = C.Win_t() + (size_t)l * NP * DM; j.ldk = DM;
        if (r < IT_IN1) { j.k0 = 64 * (r / 416); j.ns = 32 * (r % 416); j.nd = j.ns; return j; } r -= IT_IN1;
        if (r < IT_IN2) { j.k0 = 64 * (r / 480); j.ns = S_NZ + 32 * (r % 480); j.nd = C_NZ + 32 * (r % 480); return j; } r -= IT_IN2;
        j.k0 = 64 * (r >> 1); j.ns = S_NG + 32 * (r & 1); j.nvalid = (r & 1) ? 16 : 32; j.WT = C.Wg_t() + (size_t)l * 64 * DM; j.nd = 32 * (r & 1); return j; }
    r -= IT_IN1 + IT_IN2 + IT_ING;
    if (r < IT_UA) { j.W = C.w_up_a + (size_t)l * 2048 * DM; j.ldw = DM; j.k0 = 64 * (r / 128); j.ns = 32 * (r % 128); j.WT = C.Wup_t() + (size_t)l * DM * YK; j.ldk = YK; j.nd = j.ns; return j; } r -= IT_UA;
    if (r < IT_UA) { j.W = C.w_up_b + (size_t)l * 2048 * DM; j.ldw = DM; j.k0 = 64 * (r / 128); j.ns = 32 * (r % 128); j.WT = C.Wup_t() + (size_t)l * DM * YK + 2048; j.ldk = YK; j.nd = j.ns; return j; } r -= IT_UA;
    if (r < IT_UX) { j.W = C.w_up_x + (size_t)l * 512 * DM; j.ldw = DM; j.k0 = 64 * (r / 128); j.ns = 32 * (r % 128); j.WT = C.Wup_t() + (size_t)l * DM * YK + 4096; j.ldk = YK; j.nd = j.ns; return j; } r -= IT_UX;
    if (r < IT_O) { j.W = C.w_out + (size_t)l * DM * DM; j.ldw = DM; j.k0 = 64 * (r / 128); j.ns = 32 * (r % 128); j.WT = C.Wo_t() + (size_t)l * DM * DM; j.ldk = DM; j.nd = j.ns; return j; } r -= IT_O;
    if (r < 2 * IT_W1) { const int c = r / IT_W1; r -= c * IT_W1; j.W = C.cmp_w1 + (size_t)(l * 2 + c) * 4096 * 128; j.ldw = 128; j.k0 = 64 * (r >> 2); j.ns = 32 * (r & 3); j.WT = C.W1_t() + (size_t)(l * 2 + c) * 128 * 4096; j.ldk = 4096; j.nd = j.ns; return j; } r -= 2 * IT_W1;
    { const int c = r / IT_W2; r -= c * IT_W2; j.W = C.cmp_w2 + (size_t)(l * 2 + c) * 128 * 128; j.ldw = 128; j.k0 = 64 * (r >> 2); j.ns = 32 * (r & 3); j.WT = C.W2_t() + (size_t)(l * 2 + c) * 128 * 128; j.ldk = 128; j.nd = j.ns; return j; }
}
__device__ __forceinline__ void p0_prologue(const Ctx& C, LAS unsigned char* lds) {
    const int tid = tid_now(), lane = tid & 63, wave = __builtin_amdgcn_readfirstlane(tid >> 6);
    LAS float* scr = (LAS float*)(lds + wave * 16384);
    const int gw = blockIdx.x * NWAVES + wave, NGW = C.G * NWAVES;
    for (int it = gw; it < NLAY * IT_MKV; it += NGW) { const int l = it / IT_MKV, r = it - l * IT_MKV;
        TrJob j; j.W = C.w_mem_kv + (size_t)l * DM * 1024; j.gs = C.mem_norm_g + l * DM; j.WT = C.Wmkv_t(); j.ldw = 1024; j.k0 = 64 * (r >> 5); j.ns = 32 * (r & 31); j.nvalid = 32; j.ldk = DM; j.nd = l * 1024 + j.ns;
        TrRegs R; tr_load(R, j, lane); tr_store(R, j, scr, lane); }
    for (int row = gw; row < TOK; row += NGW) {
        const f32x4* xr = (const f32x4*)(C.x + (size_t)row * DM) + lane; u32x2* ob = (u32x2*)(C.xb() + (size_t)row * DM) + lane; float ss = 0.f;
#pragma unroll
        for (int j = 0; j < 16; ++j) { const f32x4 v = xr[64 * j]; ss += (v[0] * v[0] + v[1] * v[1]) + (v[2] * v[2] + v[3] * v[3]); u32x2 o; o.x = cvt_pk_bf16(v[0], v[1]); o.y = cvt_pk_bf16(v[2], v[3]); ob[64 * j] = o; }
        C.ssqp()[(size_t)row * 64 + lane] = ss;
    }
    for (int row = gw; row < NBAT * 256; row += NGW) {
        const f32x4* xr = (const f32x4*)(C.mem + (size_t)row * DM) + lane; u32x2* ob = (u32x2*)(C.memb() + (size_t)row * DM) + lane; float ss = 0.f;
#pragma unroll
        for (int j = 0; j < 16; ++j) { const f32x4 v = xr[64 * j]; ss += (v[0] * v[0] + v[1] * v[1]) + (v[2] * v[2] + v[3] * v[3]); u32x2 o; o.x = cvt_pk_bf16(v[0], v[1]); o.y = cvt_pk_bf16(v[2], v[3]); ob[64 * j] = o; }
        ss = wave_sum(ss);
        if (lane == 0) C.rstdm()[row] = 1.0f / sqrtf(ss * (1.0f / DM) + EPS);
    }
}
__device__ __forceinline__ void p0_tables(const Ctx& C) {
    const int tid = tid_now(), lane = tid & 63, wave = __builtin_amdgcn_readfirstlane(tid >> 6);
    const int gw = blockIdx.x * NWAVES + wave, NGW = C.G * NWAVES;
    for (int e = blockIdx.x * 512 + tid; e < SEQ * 64; e += C.G * 512) {
        const int s = e >> 6, i = e & 63;
        double f = 1.0; const double rr = 0.86596432336006535;
        for (int k = 0; k < i; ++k) f *= rr;
        const double a = (double)s * f; const double TWO_PI = 6.283185307179586476925;
        const double kq = __builtin_rint(a / TWO_PI); const double t = a - kq * TWO_PI, t2 = t * t;
        double cs = 1.0, sn = t, term_c = 1.0, term_s = t;
#pragma unroll 1
        for (int k = 1; k <= 13; ++k) { term_c *= -t2 / (double)((2 * k - 1) * (2 * k)); term_s *= -t2 / (double)((2 * k) * (2 * k + 1)); cs += term_c; sn += term_s; }
        C.cost()[e] = (float)cs; C.sint()[e] = (float)sn;
    }
    for (int o = gw; o < NLAY * 2 * 128; o += NGW) {
        const int lc = o >> 7, j = o & 127; const float* pp = C.cmp_pos + (size_t)lc * 4096; const float* ww = C.cmp_w1 + (size_t)lc * 4096 * 128 + j; float s = 0.f;
        { float s1 = 0.f, s2 = 0.f, s3 = 0.f;
#pragma unroll 4
          for (int f = lane; f < 4096; f += 256) { s += pp[f] * ww[(size_t)f * 128]; s1 += pp[f + 64] * ww[(size_t)(f + 64) * 128]; s2 += pp[f + 128] * ww[(size_t)(f + 128) * 128]; s3 += pp[f + 192] * ww[(size_t)(f + 192) * 128]; }
          s = (s + s1) + (s2 + s3); }
        s = wave_sum(s);
        if (lane == 0) C.pb()[o] = s;
    }
}
__device__ __forceinline__ void p0_convert(const Ctx& C, LAS unsigned char* lds, unsigned* qctr) {
    const int tid = tid_now(), lane = tid & 63, wave = __builtin_amdgcn_readfirstlane(tid >> 6);
    LAS float* scr = (LAS float*)(lds + wave * 16384);
    int qcur = 0, qend = 0;
#define TR_NEXT(dst) do { if (qcur == qend) { int b_ = 0; if (lane == 0) b_ = (int)atomicAdd(qctr, (unsigned)TRCH); b_ = __builtin_amdgcn_readfirstlane(b_); qcur = b_; qend = (b_ + TRCH < TR_ITEMS) ? b_ + TRCH : TR_ITEMS; } \
        if (qcur < qend) { dst = qcur; ++qcur; } else { dst = -1; qend = qcur; } } while (0)
    int it; TR_NEXT(it);
    if (it >= 0) {
        TrJob cur = tr_decode(C, it); TrRegs A; tr_load(A, cur, lane);
        for (;;) {
            int nx; TR_NEXT(nx); TrJob nj = cur; TrRegs B = A;
            if (nx >= 0) { nj = tr_decode(C, nx); tr_load(B, nj, lane); }
            tr_store(A, cur, scr, lane);
            if (nx < 0) break;
            cur = nj; A = B;
        }
    }
#undef TR_NEXT
}

__device__ __forceinline__ void rstd_phase(const Ctx& C) {
    const int tid = tid_now(), lane = tid & 63, wave = tid >> 6; const int gw = blockIdx.x * NWAVES + wave, NGW = C.G * NWAVES;
    for (int row0 = gw; row0 < TOK; row0 += 4 * NGW) { float v[4];
#pragma unroll
        for (int k = 0; k < 4; ++k) { const int row = row0 + k * NGW; v[k] = row < TOK ? C.ssqp()[(size_t)row * 64 + lane] : 0.f; }
#pragma unroll
        for (int k = 0; k < 4; ++k) { const int row = row0 + k * NGW; const float s = wave_sum(v[k]); if (lane == 0 && row < TOK) C.rstd()[row] = 1.0f / sqrtf(s * (1.0f / DM) + EPS); } }
}
__device__ __forceinline__ void final_phase(const Ctx& C) {
    const int tid = tid_now(), lane = tid & 63, wave = tid >> 6; const int gw = blockIdx.x * NWAVES + wave, NGW = C.G * NWAVES;
    for (int row = gw; row < TOK; row += NGW) {
        const float s = wave_sum(C.ssqp()[(size_t)row * 64 + lane]); const float rs = 1.0f / sqrtf(s * (1.0f / DM) + EPS);
        const u32x2* xr = (const u32x2*)(C.xb() + (size_t)row * DM) + lane; f32x4* orow = (f32x4*)(C.out + (size_t)row * DM) + lane; const f32x4* gr = (const f32x4*)C.final_g + lane;
#pragma unroll
        for (int j = 0; j < 16; ++j) { const u32x2 xv = xr[64 * j]; const f32x4 v = {bflo(xv.x), bfhi(xv.x), bflo(xv.y), bfhi(xv.y)}; orow[64 * j] = v * rs * gr[64 * j]; }
    }
}

constexpr float SL2 = 0.08838834764831845f * 1.4426950408889634f;
#define MFMA32(a, b, c) __builtin_amdgcn_mfma_f32_32x32x16_bf16((a), (b), (c), 0, 0, 0)
#define MFMA16(a, b, c) __builtin_amdgcn_mfma_f32_16x16x32_bf16((a), (b), (c), 0, 0, 0)
__device__ __forceinline__ void dma_k(LAS unsigned char* kb, const bf16* Kp, int kpitch, int tid, int w) {
#pragma unroll
    for (int q = 0; q < 2; ++q) { const int p = q * 512 + tid, row = p >> 4, c = (p & 15) ^ (row & 15);
        __builtin_amdgcn_global_load_lds((const unsigned*)(Kp + (size_t)row * kpitch + c * 8), (LAS unsigned*)(kb + (q * 512 + w * 64) * 16), 16, 0, 0); }
}
__device__ __forceinline__ void dma_v(LAS unsigned char* vb, const bf16* Vtp, int vts, int tid, int w) {
#pragma unroll
    for (int q = 0; q < 2; ++q) { const int p = q * 512 + tid, d = p >> 3, c = (p & 7) ^ ((d >> 1) & 7);
        __builtin_amdgcn_global_load_lds((const unsigned*)(Vtp + (size_t)d * vts + c * 8), (LAS unsigned*)(vb + (q * 512 + w * 64) * 16), 16, 0, 0); }
}
template <int s> __device__ __forceinline__ bf16x8 pack_step(const f32x16& x) {
    u32x4 p; p.x = cvt_pk_bf16(x[8 * s], x[8 * s + 1]); p.y = cvt_pk_bf16(x[8 * s + 2], x[8 * s + 3]); p.z = cvt_pk_bf16(x[8 * s + 4], x[8 * s + 5]); p.w = cvt_pk_bf16(x[8 * s + 6], x[8 * s + 7]);
    return __builtin_bit_cast(bf16x8, p);
}
__device__ __forceinline__ void qk_tile(f32x16& S0, f32x16& S1, const bf16x8 (&qf)[8], LAS const unsigned char* kb, int lane) {
    const int row = lane & 31, hi = lane >> 5, x = row & 15;
    LAS const unsigned char* kp = kb + row * 256;
#pragma unroll
    for (int r = 0; r < 16; ++r) { S0[r] = 0.f; S1[r] = 0.f; }
#pragma unroll
    for (int st = 0; st < 8; ++st) { const int off = ((2 * st + hi) ^ x) * 16; const bf16x8 k0 = *(LAS const bf16x8*)(kp + off); const bf16x8 k1 = *(LAS const bf16x8*)(kp + 32 * 256 + off);
        S0 = MFMA32(k0, qf[st], S0); S1 = MFMA32(k1, qf[st], S1); }
}
template <int MODE> __device__ __forceinline__ void mask_raw(f32x16& S0, f32x16& S1, int kbase, int tq, int hi) {
    const float NINF = -__builtin_inff();
#pragma unroll
    for (int r = 0; r < 16; ++r) { const int k0 = kbase + (r & 3) + 8 * (r >> 2) + 4 * hi, k1 = k0 + 32;
        if (MODE == 1) { if (16 * k0 + 31 > tq) S0[r] = NINF; if (16 * k1 + 31 > tq) S1[r] = NINF; }
        if (MODE == 2) { if (k0 > tq) S0[r] = NINF; if (k1 > tq) S1[r] = NINF; }
        if (MODE == 3) { if ((unsigned)(tq - k0) >= 512u) S0[r] = NINF; if ((unsigned)(tq - k1) >= 512u) S1[r] = NINF; } }
}
constexpr float DEFER_THR = 8.0f;
template <int MODE> __device__ __forceinline__ void attn_tile(f32x16 (&O)[4], float& m, float& l, const bf16x8 (&qf)[8], LAS const unsigned char* kb, LAS const unsigned char* vb,
                                                                           int lane, int kbase, int tq, bool selbit, bool masked) {
    const float NINF = -__builtin_inff();
    f32x16 S0, S1;
    qk_tile(S0, S1, qf, kb, lane);
    if (MODE != 0 && masked) mask_raw<MODE>(S0, S1, kbase, tq, lane >> 5);
    float mt = NINF;
#pragma unroll
    for (int r = 0; r < 16; ++r) mt = fmaxf(mt, fmaxf(S0[r], S1[r]));
    mt = fmaxf(mt, __shfl_xor(mt, 32)) * SL2;
    if (MODE == 2) mt = selbit ? mt : NINF;
    const bool need = mt > m + DEFER_THR;
    if (__builtin_amdgcn_ballot_w64(need) != 0ull) {
        const float mn = need ? mt : m; const float alpha = __builtin_amdgcn_exp2f(m - mn); m = mn; l *= alpha;
#pragma unroll
        for (int db = 0; db < 4; ++db) O[db] = O[db] * alpha;
    }
    float nb = -m; if (MODE == 2) nb = selbit ? nb : NINF;
    float ls = 0.f;
#pragma unroll
    for (int r = 0; r < 16; ++r) { S0[r] = __builtin_amdgcn_exp2f(__builtin_fmaf(S0[r], SL2, nb)); S1[r] = __builtin_amdgcn_exp2f(__builtin_fmaf(S1[r], SL2, nb)); ls += S0[r] + S1[r]; }
    l += ls;
    const int vrow = lane & 31, vhi = lane >> 5, vx = (vrow >> 1) & 7;
    LAS const unsigned char* vp = vb + vrow * 128;
#define PV_STEP(st4, pfexpr) { const bf16x8 pf = pfexpr; const int voff = ((2 * (st4) + vhi) ^ vx) * 16; _Pragma("unroll") for (int db = 0; db < 4; ++db) { const bf16x8 vf = *(LAS const bf16x8*)(vp + db * 32 * 128 + voff); O[db] = MFMA32(vf, pf, O[db]); } }
    PV_STEP(0, pack_step<0>(S0)) PV_STEP(1, pack_step<1>(S0)) PV_STEP(2, pack_step<0>(S1)) PV_STEP(3, pack_step<1>(S1))
#undef PV_STEP
}
template <int MODE> __device__ __forceinline__ void attn_branch(f32x16 (&O)[4], float& m, float& l, const bf16x8 (&qf)[8], LAS unsigned char* lds, const bf16* Kb, int kpitch, const bf16* Vtb, int vts,
                                                                int jlo, int jhi, int tq, unsigned selmask, int tid, int lane, int w) {
    dma_k(lds + A_KB0, Kb + (size_t)jlo * 64 * kpitch, kpitch, tid, w); dma_v(lds + A_VB0, Vtb + jlo * 64, vts, tid, w);
    asm volatile("s_waitcnt vmcnt(0)" ::: "memory");
    __syncthreads();
    int buf = 0;
    for (int j = jlo; j <= jhi; ++j) {
        if (j < jhi) { dma_k(lds + (buf ? A_KB0 : A_KB1), Kb + (size_t)(j + 1) * 64 * kpitch, kpitch, tid, w); dma_v(lds + (buf ? A_VB0 : A_VB1), Vtb + (j + 1) * 64, vts, tid, w); }
        const bool masked = (MODE == 1) || (MODE == 2 && j == jhi) || (MODE == 3 && (j == jlo || j == jhi));
        attn_tile<MODE>(O, m, l, qf, lds + (buf ? A_KB1 : A_KB0), lds + (buf ? A_VB1 : A_VB0), lane, j * 64, tq, ((selmask >> j) & 1u) != 0u, masked);
        asm volatile("s_waitcnt vmcnt(0)" ::: "memory");
        __syncthreads();
        buf ^= 1;
    }
}
__device__ __forceinline__ void load_q(bf16x8 (&qf)[8], const bf16* qp  ) {
#pragma unroll
    for (int st = 0; st < 8; ++st) qf[st] = *(const bf16x8*)(qp + st * 16);
}
__device__ __forceinline__ float branch_inv(float l) { const float lt = l + __shfl_xor(l, 32); return lt > 0.f ? 1.0f / lt : 0.f; }

__device__ __forceinline__ void nsa_unit(const Ctx& C, int b, int g, int qb, LAS unsigned char* lds) {
    const int tid = tid_now(), lane = tid & 63, w = __builtin_amdgcn_readfirstlane(tid >> 6), hh = w >> 1, th = w & 1, c = lane & 31, hi = lane >> 5;
    const int tq = 64 * qb + 32 * th + c, head = g * 4 + hh; const size_t row = (size_t)b * SEQ + tq;
    const bf16* prow = C.P() + row * NP;
    bf16x8 qf[8];
    load_q(qf, prow + C_NQ + head * 128 + hi * 8);
    const float* ngp = C.ng() + row * 48 + head * 3; const float g0 = ngp[0], g1 = ngp[1], g2 = ngp[2];
    const size_t bg = (size_t)(b * 4 + g);
    f32x16 O[4]; float m, l;
    unsigned* tsc = C.tsc() + ((size_t)(blockIdx.x * NWAVES + w) * 32) * 64 + lane;
#pragma unroll
    for (int db = 0; db < 4; ++db)
#pragma unroll
        for (int r = 0; r < 16; ++r) O[db][r] = 0.f;
    m = -1e30f; l = 0.f;
    const bf16* Kc = C.Kc() + bg * 128 * 128; const bf16* Vtc = C.Vtc() + bg * 128 * 128;
    attn_branch<1>(O, m, l, qf, lds, Kc, 128, Vtc, 128, 0, (qb >= 16) ? 1 : 0, tq, 0u, tid, lane, w);
    const float inv0 = branch_inv(l);
    { const float sc = g0 * inv0;
#pragma unroll
      for (int db = 0; db < 4; ++db)
#pragma unroll
          for (int r = 0; r < 8; ++r) tsc[(db * 8 + r) * 64] = cvt_pk_bf16(O[db][2 * r] * sc, O[db][2 * r + 1] * sc); }
    unsigned selmask = 0xffffffffu;
    if (qb >= 16) {
        dma_k(lds + A_KB0, Kc, 128, tid, w); dma_k(lds + A_KB1, Kc + 64 * 128, 128, tid, w);
        asm volatile("s_waitcnt vmcnt(0)" ::: "memory");
        __syncthreads();
        float Gv[16], Ev[16];
#pragma unroll
        for (int t = 0; t < 2; ++t) {
            f32x16 S0, S1;
            qk_tile(S0, S1, qf, lds + (t ? A_KB1 : A_KB0), lane);
            mask_raw<1>(S0, S1, 64 * t, tq, hi);
#pragma unroll
            for (int r = 0; r < 16; ++r) { S0[r] = __builtin_amdgcn_exp2f(__builtin_fmaf(S0[r], SL2, -m)) * inv0; S1[r] = __builtin_amdgcn_exp2f(__builtin_fmaf(S1[r], SL2, -m)) * inv0; }
#pragma unroll
            for (int q4 = 0; q4 < 4; ++q4) {
                Gv[8 * t + q4] = (S0[4 * q4] + S0[4 * q4 + 1]) + (S0[4 * q4 + 2] + S0[4 * q4 + 3]); Ev[8 * t + q4] = S0[4 * q4 + 3];
                Gv[8 * t + 4 + q4] = (S1[4 * q4] + S1[4 * q4 + 1]) + (S1[4 * q4 + 2] + S1[4 * q4 + 3]); Ev[8 * t + 4 + q4] = S1[4 * q4 + 3]; }
        }
        float rv[16];
#pragma unroll
        for (int i = 0; i < 16; ++i) rv[i] = __shfl_xor(Ev[i], 32);
        LAS float* impw = (LAS float*)(lds + A_IMPW) + (w * 32 + c) * 33;
#pragma unroll
        for (int i = 0; i < 16; ++i) { const float add = hi ? rv[i] : (i > 0 ? rv[i > 0 ? i - 1 : 0] : 0.f); impw[2 * i + hi] = Gv[i] + add; }
        __syncthreads();
        {
            const int tk = tid >> 3, part = tid & 7, tth = tk >> 5, cc = tk & 31; LAS const float* iw = (LAS const float*)(lds + A_IMPW); LAS float* is = (LAS float*)(lds + A_IMPS);
#pragma unroll
            for (int jj = 0; jj < 4; ++jj) { const int j = 4 * part + jj; float s = 0.f;
#pragma unroll
                for (int h4 = 0; h4 < 4; ++h4) s += iw[((2 * h4 + tth) * 32 + cc) * 33 + j];
                is[tk * 33 + j] = s; }
        }
        __syncthreads();
        {
            const int tk = tid >> 3, part = tid & 7; LAS const float* is = (LAS const float*)(lds + A_IMPS) + tk * 33; const float PINF = __builtin_inff();
            unsigned bits = 0u;
#pragma unroll
            for (int jj = 0; jj < 4; ++jj) { const int j = 4 * part + jj;
                const float vj = (j > qb) ? -PINF : ((j == 0 || j == qb || j == qb - 1) ? PINF : is[j]); int cnt = 0;
                for (int k = 0; k < 32; ++k) { const float vk = (k > qb) ? -PINF : ((k == 0 || k == qb || k == qb - 1) ? PINF : is[k]); cnt += (vk > vj || (vk == vj && k < j)) ? 1 : 0; }
                if (cnt < 16) bits |= 1u << j; }
            bits |= __shfl_xor(bits, 1); bits |= __shfl_xor(bits, 2); bits |= __shfl_xor(bits, 4);
            if (part == 0) ((LAS unsigned*)(lds + A_SELM))[tk] = bits;
        }
        __syncthreads();
        selmask = ((LAS const unsigned*)(lds + A_SELM))[32 * th + c];
    }
    { const float* cs = C.cost() + (size_t)tq * 64 + hi * 8; const float* sn = C.sint() + (size_t)tq * 64 + hi * 8;
#pragma unroll
      for (int st = 0; st < 4; ++st) {
          const f32x4 c0 = *(const f32x4*)(cs + st * 16), c1 = *(const f32x4*)(cs + st * 16 + 4), s0 = *(const f32x4*)(sn + st * 16), s1 = *(const f32x4*)(sn + st * 16 + 4);
          const u32x4 a = __builtin_bit_cast(u32x4, qf[st]), bq = __builtin_bit_cast(u32x4, qf[st + 4]); u32x4 oa, ob;
#pragma unroll
          for (int e2 = 0; e2 < 4; ++e2) { const float x1l = bflo(a[e2]), x1h = bfhi(a[e2]), x2l = bflo(bq[e2]), x2h = bfhi(bq[e2]);
              const float cl = (e2 < 2) ? c0[2 * e2] : c1[2 * e2 - 4], ch = (e2 < 2) ? c0[2 * e2 + 1] : c1[2 * e2 - 3], sl = (e2 < 2) ? s0[2 * e2] : s1[2 * e2 - 4], sh = (e2 < 2) ? s0[2 * e2 + 1] : s1[2 * e2 - 3];
              oa[e2] = cvt_pk_bf16(x1l * cl - x2l * sl, x1h * ch - x2h * sh); ob[e2] = cvt_pk_bf16(x2l * cl + x1l * sl, x2h * ch + x1h * sh); }
          qf[st] = __builtin_bit_cast(bf16x8, oa); qf[st + 4] = __builtin_bit_cast(bf16x8, ob); } }
#pragma unroll
    for (int db = 0; db < 4; ++db)
#pragma unroll
        for (int r = 0; r < 16; ++r) O[db][r] = 0.f;
    m = -1e30f; l = 0.f;
    attn_branch<2>(O, m, l, qf, lds, C.Kr() + bg * SEQ * 128, 128, C.Vt() + bg * 128 * SEQ, SEQ, 0, qb, tq, selmask, tid, lane, w);
    { const float sc = g1 * branch_inv(l);
#pragma unroll
      for (int db = 0; db < 4; ++db)
#pragma unroll
          for (int r = 0; r < 8; ++r) { const unsigned t = tsc[(db * 8 + r) * 64]; tsc[(db * 8 + r) * 64] = cvt_pk_bf16(bflo(t) + O[db][2 * r] * sc, bfhi(t) + O[db][2 * r + 1] * sc); } }
#pragma unroll
    for (int db = 0; db < 4; ++db)
#pragma unroll
        for (int r = 0; r < 16; ++r) O[db][r] = 0.f;
    m = -1e30f; l = 0.f;
    attn_branch<3>(O, m, l, qf, lds, C.Kr() + (16 + bg) * SEQ * 128, 128, C.Vt() + (16 + bg) * 128 * SEQ, SEQ, (qb > 8) ? qb - 8 : 0, qb, tq, 0u, tid, lane, w);
    { const float sc = g2 * branch_inv(l);
      const bf16* zp = prow + C_NZ + head * 128 + 4 * hi; bf16* op = C.Y() + row * YK + 2048 + head * 128 + 4 * hi;
#pragma unroll
      for (int db = 0; db < 4; ++db)
#pragma unroll
          for (int q4 = 0; q4 < 4; ++q4) { const u32x2 zz = *(const u32x2*)(zp + 32 * db + 8 * q4); const unsigned t0 = tsc[(db * 8 + 2 * q4) * 64], t1 = tsc[(db * 8 + 2 * q4 + 1) * 64];
              const float o0 = (bflo(t0) + O[db][4 * q4] * sc) * siluf_(bflo(zz.x)), o1 = (bfhi(t0) + O[db][4 * q4 + 1] * sc) * siluf_(bfhi(zz.x));
              const float o2 = (bflo(t1) + O[db][4 * q4 + 2] * sc) * siluf_(bflo(zz.y)), o3 = (bfhi(t1) + O[db][4 * q4 + 3] * sc) * siluf_(bfhi(zz.y));
              u32x2 ov; ov.x = cvt_pk_bf16(o0, o1); ov.y = cvt_pk_bf16(o2, o3); *(u32x2*)(op + 32 * db + 8 * q4) = ov; } }
}

__device__ __forceinline__ void mem_unit(const Ctx& C, int l_, int b, int h, int tb, LAS unsigned char* lds) {
    const int tid = tid_now(), lane = tid & 63, w = __builtin_amdgcn_readfirstlane(tid >> 6), c = lane & 31, hi = lane >> 5;
    const int tq = 256 * tb + 32 * w + c; const size_t row = (size_t)b * SEQ + tq; const bf16* prow = C.P() + row * NP;
    bf16x8 qf[8];
    load_q(qf, prow + C_XQ + h * 128 + hi * 8);
    f32x16 O[4]; float m = -1e30f, l = 0.f;
#pragma unroll
    for (int db = 0; db < 4; ++db)
#pragma unroll
        for (int r = 0; r < 16; ++r) O[db][r] = 0.f;
    const size_t hb = (size_t)((l_ * 4 + b) * 4 + h);
    attn_branch<0>(O, m, l, qf, lds, C.memK() + hb * 256 * 128, 128, C.memVt() + hb * 128 * 256, 256, 0, 3, tq, 0u, tid, lane, w);
    const float sc = branch_inv(l);
    const bf16* zp = prow + C_XZ + h * 128 + 4 * hi; bf16* op = C.Y() + row * YK + 4096 + h * 128 + 4 * hi;
#pragma unroll
    for (int db = 0; db < 4; ++db)
#pragma unroll
        for (int q4 = 0; q4 < 4; ++q4) { const u32x2 zz = *(const u32x2*)(zp + 32 * db + 8 * q4);
            u32x2 ov; ov.x = cvt_pk_bf16(O[db][4 * q4] * sc * siluf_(bflo(zz.x)), O[db][4 * q4 + 1] * sc * siluf_(bfhi(zz.x)));
            ov.y = cvt_pk_bf16(O[db][4 * q4 + 2] * sc * siluf_(bflo(zz.y)), O[db][4 * q4 + 3] * sc * siluf_(bfhi(zz.y))); *(u32x2*)(op + 32 * db + 8 * q4) = ov; }
}

__device__ __forceinline__ void cmp_item(const Ctx& C, int l_, int item, LAS unsigned char* lds) {
    const int tid = tid_now(), lane = tid & 63, w = __builtin_amdgcn_readfirstlane(tid >> 6), r16 = lane & 15, quad = lane >> 4;
    const int nb = item & 7, c = (item >> 3) & 1, g = (item >> 4) & 3, b = item >> 6, n0 = 16 * nb;
    int n = n0 + r16; if (n > 126) n = 126;
    f32x4 acc[8];
#pragma unroll
    for (int cb = 0; cb < 8; ++cb) acc[cb] = (f32x4){0.f, 0.f, 0.f, 0.f};
    const bf16* W1 = C.W1_t() + (size_t)(l_ * 2 + c) * 128 * 4096;
    const bf16* abase = C.P() + ((size_t)b * SEQ + 16 * n) * NP + C_KV + (c * 4 + g) * 128 + quad * 8;
    bf16x8 av[4][4];
#pragma unroll
    for (int ll = 0; ll < 4; ++ll)
#pragma unroll
        for (int ks = 0; ks < 4; ++ks) av[ll][ks] = *(const bf16x8*)(abase + (size_t)(4 * w + ll) * NP + ks * 32);
#pragma unroll
    for (int ll = 0; ll < 4; ++ll) { const int lpos = 4 * w + ll; const bf16* bp = W1 + (size_t)r16 * 4096 + lpos * 128 + quad * 8;
#pragma unroll
        for (int ks = 0; ks < 4; ++ks) { bf16x8 bv[8];
#pragma unroll
            for (int cb = 0; cb < 8; ++cb) bv[cb] = *(const bf16x8*)(bp + (size_t)cb * 16 * 4096 + ks * 32);
#pragma unroll
            for (int cb = 0; cb < 8; ++cb) acc[cb] = MFMA16(av[ll][ks], bv[cb], acc[cb]); } }
    LAS float* red = (LAS float*)lds;
#pragma unroll
    for (int cb = 0; cb < 8; ++cb)
#pragma unroll
        for (int i = 0; i < 4; ++i) red[(w * 16 + 4 * quad + i) * 128 + 16 * cb + r16] = acc[cb][i];
    __syncthreads();
    LAS bf16* hid = (LAS bf16*)(lds + 65536);
#pragma unroll
    for (int q = 0; q < 4; ++q) { const int o = tid + 512 * q, rr = o >> 7, col = o & 127; float s = C.pb()[(l_ * 2 + c) * 128 + col];
#pragma unroll
        for (int ww = 0; ww < 8; ++ww) s += red[(ww * 16 + rr) * 128 + col];
        hid[rr * 136 + col] = f2bf(siluf_(s)); }
    __syncthreads();
    const bf16* W2 = C.W2_t() + (size_t)(l_ * 2 + c) * 128 * 128; f32x4 a2 = (f32x4){0.f, 0.f, 0.f, 0.f};
#pragma unroll
    for (int ks = 0; ks < 4; ++ks) { const bf16x8 a = *(LAS const bf16x8*)(hid + r16 * 136 + ks * 32 + quad * 8); const bf16x8 bb = *(const bf16x8*)(W2 + (size_t)(16 * w + r16) * 128 + ks * 32 + quad * 8); a2 = MFMA16(a, bb, a2); }
    const size_t bg = (size_t)(b * 4 + g); const int col = 16 * w + r16;
#pragma unroll
    for (int i = 0; i < 4; ++i) { const int nn = n0 + 4 * quad + i; const bf16 v = f2bf(nn < 127 ? a2[i] : 0.f);
        if (c == 0) C.Kc()[(bg * 128 + nn) * 128 + col] = v; else C.Vtc()[(bg * 128 + col) * 128 + ((nn & ~15) | perm16(nn & 15))] = v; }
    __syncthreads();
}
__device__ __forceinline__ void ropevt_item(const Ctx& C, int item, LAS unsigned char* lds) {
    const int tid = tid_now(); const int j0 = (item & 7) * 4, g = (item >> 3) & 3, b = (item >> 5) & 3, brk = item >> 7, br = brk + 1;
    const size_t bg = (size_t)(brk * 16 + b * 4 + g);
    {
        const int s = tid >> 3, d0 = 8 * (tid & 7); u32x4 a[4], bq[4]; f32x4 c0[4], c1[4], s0[4], s1[4];
#pragma unroll
        for (int u = 0; u < 4; ++u) { const int tok = 64 * (j0 + u) + s; const bf16* src = C.P() + ((size_t)b * SEQ + tok) * NP + C_KV + ((br * 2 + 0) * 4 + g) * 128 + d0;
            a[u] = *(const u32x4*)src; bq[u] = *(const u32x4*)(src + 64);
            const float* cs = C.cost() + (size_t)tok * 64 + d0; const float* sn = C.sint() + (size_t)tok * 64 + d0;
            c0[u] = *(const f32x4*)cs; c1[u] = *(const f32x4*)(cs + 4); s0[u] = *(const f32x4*)sn; s1[u] = *(const f32x4*)(sn + 4); }
#pragma unroll
        for (int u = 0; u < 4; ++u) { const int tok = 64 * (j0 + u) + s; u32x4 oa, ob;
#pragma unroll
            for (int e2 = 0; e2 < 4; ++e2) { const float x1l = bflo(a[u][e2]), x1h = bfhi(a[u][e2]), x2l = bflo(bq[u][e2]), x2h = bfhi(bq[u][e2]);
                const float cl = (e2 < 2) ? c0[u][2 * e2] : c1[u][2 * e2 - 4], ch = (e2 < 2) ? c0[u][2 * e2 + 1] : c1[u][2 * e2 - 3], sl = (e2 < 2) ? s0[u][2 * e2] : s1[u][2 * e2 - 4], sh = (e2 < 2) ? s0[u][2 * e2 + 1] : s1[u][2 * e2 - 3];
                oa[e2] = cvt_pk_bf16(x1l * cl - x2l * sl, x1h * ch - x2h * sh); ob[e2] = cvt_pk_bf16(x2l * cl + x1l * sl, x2h * ch + x1h * sh); }
            bf16* dst = C.Kr() + (bg * SEQ + tok) * 128 + d0; *(u32x4*)dst = oa; *(u32x4*)(dst + 64) = ob; }
    }
    {
        LAS bf16* vt = (LAS bf16*)lds; u32x4 v[8];
#pragma unroll
        for (int q = 0; q < 8; ++q) { const int id = tid + 512 * (q & 1), s = id >> 4, ch = id & 15, u = q >> 1;
            v[q] = *(const u32x4*)(C.P() + ((size_t)b * SEQ + 64 * (j0 + u) + s) * NP + C_KV + ((br * 2 + 1) * 4 + g) * 128 + ch * 8); }
#pragma unroll
        for (int q = 0; q < 8; ++q) { const int id = tid + 512 * (q & 1), s = id >> 4, ch = id & 15, u = q >> 1;
            LAS unsigned* d = (LAS unsigned*)(vt + u * (64 * 130) + s * 130 + ch * 8); d[0] = v[q].x; d[1] = v[q].y; d[2] = v[q].z; d[3] = v[q].w; }
        __syncthreads();
#pragma unroll
        for (int q = 0; q < 8; ++q) { const int id = tid + 512 * (q & 1), d = id >> 3, pc = id & 7, u = q >> 1; unsigned short e[8];
#pragma unroll
            for (int k = 0; k < 8; ++k) { const int key = 16 * (pc >> 1) + 8 * (k >> 2) + 4 * (pc & 1) + (k & 3); e[k] = vt[u * (64 * 130) + key * 130 + d]; }
            u32x4 o; o.x = e[0] | ((unsigned)e[1] << 16); o.y = e[2] | ((unsigned)e[3] << 16); o.z = e[4] | ((unsigned)e[5] << 16); o.w = e[6] | ((unsigned)e[7] << 16);
            *(u32x4*)(C.Vt() + (bg * 128 + d) * SEQ + 64 * (j0 + u) + 8 * pc) = o; }
        __syncthreads();
    }
}
__device__ __forceinline__ void gate_item(const Ctx& C, int l_, int item, LAS unsigned char* lds) {
    const int tid = tid_now(), lane = tid & 63, w = __builtin_amdgcn_readfirstlane(tid >> 6), r16 = lane & 15, quad = lane >> 4, rb = w >> 2, kq = w & 3;
    const bf16* ap = C.xb() + (size_t)(32 * item + 16 * rb + r16) * DM + kq * 1024 + quad * 8;
    const bf16* bp = C.Wg_t() + (size_t)l_ * 64 * DM + (size_t)r16 * DM + kq * 1024 + quad * 8;
    f32x4 acc[3];
#pragma unroll
    for (int cb = 0; cb < 3; ++cb) acc[cb] = (f32x4){0.f, 0.f, 0.f, 0.f};
#pragma unroll
    for (int k0 = 0; k0 < 32; k0 += 16) { bf16x8 ag[16];
#pragma unroll
        for (int ks = 0; ks < 16; ++ks) ag[ks] = *(const bf16x8*)(ap + (k0 + ks) * 32);
#pragma unroll
        for (int ks = 0; ks < 16; ++ks) {
#pragma unroll
            for (int cb = 0; cb < 3; ++cb) { const bf16x8 bb = *(const bf16x8*)(bp + (size_t)cb * 16 * DM + (k0 + ks) * 32); acc[cb] = MFMA16(ag[ks], bb, acc[cb]); } } }
    LAS float* red = (LAS float*)lds;
#pragma unroll
    for (int cb = 0; cb < 3; ++cb)
#pragma unroll
        for (int i = 0; i < 4; ++i) red[(w * 16 + 4 * quad + i) * 48 + 16 * cb + r16] = acc[cb][i];
    __syncthreads();
    for (int o = tid; o < 32 * 48; o += 512) { const int rr = o / 48, col = o - rr * 48, rb2 = rr >> 4, r2 = rr & 15; float s = 0.f;
#pragma unroll
        for (int q = 0; q < 4; ++q) s += red[((rb2 * 4 + q) * 16 + r2) * 48 + col];
        const int row = 32 * item + rr; C.ng()[(size_t)row * 48 + col] = sigmoidf_(s * C.rstd()[row]); }
    __syncthreads();
}
__device__ __forceinline__ void memvt_item(const Ctx& C, int item, LAS unsigned char* lds) {
    const int tid = tid_now(); const int t = item & 3, h = (item >> 2) & 3, b = (item >> 4) & 3, l_ = item >> 6;
    LAS bf16* vt = (LAS bf16*)lds;
#pragma unroll
    for (int q = 0; q < 2; ++q) { const int id = tid + 512 * q, s = id >> 4, ch = id & 15;
        *(u32x4*)(C.memK() + ((size_t)((l_ * 4 + b) * 4 + h) * 256 + 64 * t + s) * 128 + ch * 8) = *(const u32x4*)(C.MKV() + ((size_t)b * 256 + 64 * t + s) * 4096 + l_ * 1024 + h * 128 + ch * 8);
        const u32x4 v = *(const u32x4*)(C.MKV() + ((size_t)b * 256 + 64 * t + s) * 4096 + l_ * 1024 + 512 + h * 128 + ch * 8);
        LAS unsigned* d = (LAS unsigned*)(vt + s * 130 + ch * 8); d[0] = v.x; d[1] = v.y; d[2] = v.z; d[3] = v.w; }
    __syncthreads();
    const size_t hb = (size_t)((l_ * 4 + b) * 4 + h);
#pragma unroll
    for (int q = 0; q < 2; ++q) { const int id = tid + 512 * q, d = id >> 3, pc = id & 7; unsigned short e[8];
#pragma unroll
        for (int k = 0; k < 8; ++k) { const int key = 16 * (pc >> 1) + 8 * (k >> 2) + 4 * (pc & 1) + (k & 3); e[k] = vt[key * 130 + d]; }
        u32x4 o; o.x = e[0] | ((unsigned)e[1] << 16); o.y = e[2] | ((unsigned)e[3] << 16); o.z = e[4] | ((unsigned)e[5] << 16); o.w = e[6] | ((unsigned)e[7] << 16);
        *(u32x4*)(C.memVt() + (hb * 128 + d) * 256 + 64 * t + 8 * pc) = o; }
    __syncthreads();
}
__device__ __forceinline__ void conv_item(const Ctx& C, int l_, int item) {
    const int tid = tid_now(); const int ch = (tid & 255) * 8, t0 = 64 * item + 32 * (tid >> 8), sp0 = t0 & (SEQ - 1);
    const float* cw = C.conv_w + (size_t)l_ * 3 * 2048 + ch; const float* cbv = C.conv_b + (size_t)l_ * 2048 + ch;
    float w[3][8], bias[8], u1[8], u2[8];
#pragma unroll
    for (int k = 0; k < 3; ++k) { const f32x4 a = *(const f32x4*)(cw + k * 2048), c = *(const f32x4*)(cw + k * 2048 + 4); w[k][0] = a[0]; w[k][1] = a[1]; w[k][2] = a[2]; w[k][3] = a[3]; w[k][4] = c[0]; w[k][5] = c[1]; w[k][6] = c[2]; w[k][7] = c[3]; }
    { const f32x4 a = *(const f32x4*)cbv, c = *(const f32x4*)(cbv + 4); bias[0] = a[0]; bias[1] = a[1]; bias[2] = a[2]; bias[3] = a[3]; bias[4] = c[0]; bias[5] = c[1]; bias[6] = c[2]; bias[7] = c[3]; }
    const bf16* p = C.P() + (size_t)t0 * NP + ch;
#pragma unroll
    for (int e = 0; e < 8; ++e) { u1[e] = 0.f; u2[e] = 0.f; }
    if (sp0 >= 1) { const u32x4 hv = *(const u32x4*)(p - NP + C_AH), cv = *(const u32x4*)(p - NP + C_AC);
#pragma unroll
        for (int e2 = 0; e2 < 4; ++e2) { u1[2 * e2] = bflo(hv[e2]) * bflo(cv[e2]); u1[2 * e2 + 1] = bfhi(hv[e2]) * bfhi(cv[e2]); } }
    if (sp0 >= 2) { const u32x4 hv = *(const u32x4*)(p - 2 * (size_t)NP + C_AH), cv = *(const u32x4*)(p - 2 * (size_t)NP + C_AC);
#pragma unroll
        for (int e2 = 0; e2 < 4; ++e2) { u2[2 * e2] = bflo(hv[e2]) * bflo(cv[e2]); u2[2 * e2 + 1] = bfhi(hv[e2]) * bfhi(cv[e2]); } }
    bf16* yo = C.Y() + (size_t)t0 * YK + ch;
#pragma unroll 8
    for (int s = 0; s < 32; ++s) { const bf16* ps = p + (size_t)s * NP;
        const u32x4 hv = *(const u32x4*)(ps + C_AH), cv = *(const u32x4*)(ps + C_AC), bv = *(const u32x4*)(ps + C_AB), zv = *(const u32x4*)(ps + C_AZ); u32x4 o;
#pragma unroll
        for (int e2 = 0; e2 < 4; ++e2) { const float ul = bflo(hv[e2]) * bflo(cv[e2]), uh = bfhi(hv[e2]) * bfhi(cv[e2]);
            float yl = bias[2 * e2], yh = bias[2 * e2 + 1];
            yl += w[0][2 * e2] * u2[2 * e2]; yh += w[0][2 * e2 + 1] * u2[2 * e2 + 1];
            yl += w[1][2 * e2] * u1[2 * e2]; yh += w[1][2 * e2 + 1] * u1[2 * e2 + 1];
            yl += w[2][2 * e2] * ul; yh += w[2][2 * e2 + 1] * uh;
            u2[2 * e2] = u1[2 * e2]; u2[2 * e2 + 1] = u1[2 * e2 + 1]; u1[2 * e2] = ul; u1[2 * e2 + 1] = uh;
            o[e2] = cvt_pk_bf16(bflo(bv[e2]) * yl * siluf_(bflo(zv[e2])), bfhi(bv[e2]) * yh * siluf_(bfhi(zv[e2]))); }
        *(u32x4*)(yo + (size_t)s * YK) = o; }
}


#define GAS __attribute__((address_space(1)))
typedef float f32x4g __attribute__((ext_vector_type(4)));
__device__ __noinline__ void rstd_table(const GAS float* sp0, GAS float* rg, LAS float* rt) {
    const int t = threadIdx.x, row = t >> 1, half = t & 1; const GAS float* sp = sp0 + (size_t)row * 64 + half * 32; float s = 0.f;
#pragma unroll
    for (int k = 0; k < 8; ++k) { const f32x4 v = *(const GAS f32x4*)(sp + 4 * k); s += (v[0] + v[1]) + (v[2] + v[3]); }
    const float so = __shfl_xor(s, 1); const float tot = half ? (so + s) : (s + so); const float rs = 1.0f / sqrtf(tot * (1.0f / 4096.0f) + 1e-6f);
    if (half == 0) { rt[row] = rs; rg[row] = rs; }
}
constexpr int N_PHASES = 2 + 5 * NLAY + 1;
struct Args { const float* in[16]; float* out; unsigned char* ws; int ph_lo, ph_hi, li, pad; };
__global__ void __launch_bounds__(NWAVES * 64, 2) fwd(Args args) {
    extern __shared__ __attribute__((aligned(16))) unsigned char lds_raw[];
    LAS unsigned char* lds = (LAS unsigned char*)lds_raw;
    volatile LAS unsigned* MISC = (volatile LAS unsigned*)(lds + MISC_OFF);
    const int tid = tid_now();
    Ctx C;
    C.x = args.in[0]; C.mem = args.in[1]; C.norm_g = args.in[2]; C.w_in = args.in[3]; C.conv_w = args.in[4]; C.conv_b = args.in[5]; C.cmp_pos = args.in[6]; C.cmp_w1 = args.in[7];
    C.cmp_w2 = args.in[8]; C.mem_norm_g = args.in[9]; C.w_mem_kv = args.in[10]; C.w_up_a = args.in[11]; C.w_up_b = args.in[12]; C.w_up_x = args.in[13]; C.w_out = args.in[14]; C.final_g = args.in[15];
    C.out = args.out;
    unsigned char* ws = args.ws; C.ws = ws;
    C.G = gridDim.x; { const int bx = blockIdx.x; C.vcu = (C.G % 8 == 0) ? (bx % 8) * (C.G / 8) + bx / 8 : bx; }
    for (int u = tid; u < (LDS_BYTES - RING_BYTES) / 4; u += NWAVES * 64) ((LAS unsigned*)(lds + RING_BYTES))[u] = 0u;
    __syncthreads();
    const int lo = args.ph_lo, hi = args.ph_hi;
    const bool use_bar = (hi - lo) > 1;
    XcdBarrier bar; bar.bar = (unsigned*)(ws) + CW_BAR + args.li * XCD_BAR_WORDS; bar.x = 0; bar.st = MISC + 8;
    if (use_bar) bar = xcd_barrier_post((unsigned*)(ws) + CW_BAR + args.li * XCD_BAR_WORDS, MISC + 8);
#ifndef PHMASK
#define PHMASK 0xff
#endif
#define IN(k) (lo <= (k) && (k) < hi)
#define RELAUNDER() do { size_t z_ = 0; asm volatile("" : "+s"(z_)); C.ws = ws + z_; } while (0)
#define EN(b) ((PHMASK >> (b)) & 1)
#if defined(DOUBLE_BAR)
#define SEAM(k) do { if (IN(k) && IN((k) + 1)) { xcd_barrier(bar); xcd_barrier(bar); } } while (0)
#else
#define SEAM(k) do { if (IN(k) && IN((k) + 1)) xcd_barrier(bar); } while (0)
#endif

    if (EN(0) && IN(0)) { RELAUNDER(); p0_prologue(C, lds); __syncthreads(); }
    SEAM(0);
    if (EN(1) && IN(1)) { RELAUNDER();
        pg8::Gemm g{C.memb(), C.Wmkv_t(), NBAT * 256, 4096, DM}; pg8::StaticOrder S; S.init(NBAT * 256, 4096, C.G, bx_now());
        pg8::EpiProj E{C.MKV(), 4096, C.rstdm(), nullptr, nullptr, 0, 1 << 30};
        pg8::gemm_phase<pg8::EpiProj, pg8::StaticOrder, true, true>(lds, g, S, E);
        p0_tables(C);
        p0_convert(C, lds, (unsigned*)(ws) + CW_Q + 64 * args.li);
    }
    SEAM(1);
    for (int l = 0; l < NLAY; ++l) {
        const int pA = 2 + 5 * l;
        if (EN(2) && IN(pA)) { RELAUNDER();
            if (l == 0) { for (int it = blockIdx.x; it < 256; it += C.G) memvt_item(C, it, lds); }
            pg8::Gemm g{C.xb(), C.Win_t() + (size_t)l * NP * DM, TOK, NP, DM}; pg8::StaticOrder S; S.init(TOK, NP, C.G, bx_now()); S.mix = 1;
            PG8_LAS float* rt = (PG8_LAS float*)(lds + RT_OFF); int pm0 = -1; { pg8::Unit u0; if (S.next(0, u0)) pm0 = u0.pm; }
            if (pm0 >= 0) rstd_table((const GAS float*)(C.ssqp() + (size_t)pm0 * 256 * 64), (GAS float*)(C.rstd() + pm0 * 256), rt);
            __syncthreads();
            pg8::EpiProj E{C.P(), NP, nullptr, rt, C.G8(), 3 * DM, C_MG / 256};
            pg8::gemm_phase<pg8::EpiProj, pg8::StaticOrder, true, true>(lds, g, S, E);
        }
        SEAM(pA);
        if (EN(3) && IN(pA + 1)) { RELAUNDER();
            for (int it = blockIdx.x; it < 128 + 128 + 256 + 256 + 256; it += C.G) {
                if (it < 128) { mem_unit(C, l, it >> 5, (it >> 3) & 3, it & 7, lds); }
                else if (it < 256) { conv_item(C, l, it - 128); }
                else if (it < 512) { cmp_item(C, l, it - 256, lds); }
                else if (it < 768) { ropevt_item(C, it - 512, lds); }
                else { gate_item(C, l, it - 768, lds); }
            }
        }
        SEAM(pA + 1);
        if (EN(4) && IN(pA + 2)) { RELAUNDER();
            for (int it = C.vcu; it < 256; it += C.G) { const int bg = it >> 4, pr = it & 15; nsa_unit(C, bg >> 2, bg & 3, 31 - pr, lds); nsa_unit(C, bg >> 2, bg & 3, pr, lds); }
        }
        SEAM(pA + 2);
        if (EN(5) && IN(pA + 3)) { RELAUNDER();
            pg8::Gemm g{C.Y(), C.Wup_t() + (size_t)l * DM * YK, TOK, DM, YK}; pg8::StaticOrder S; S.init(TOK, DM, C.G, bx_now());
            pg8::EpiUpF E{C.G8(), 3 * DM, DM, C.UB(), DM};
            pg8::gemm_phase<pg8::EpiUpF, pg8::StaticOrder, true, true>(lds, g, S, E);
        }
        SEAM(pA + 3);
        if (EN(6) && IN(pA + 4)) { RELAUNDER();
            pg8::Gemm g{C.UB(), C.Wo_t() + (size_t)l * DM * DM, TOK, DM, DM}; pg8::StaticOrder S; S.init(TOK, DM, C.G, bx_now());
            pg8::EpiOut E{C.xb(), C.ssqp(), DM};
            pg8::gemm_phase<pg8::EpiOut, pg8::StaticOrder, true, true>(lds, g, S, E);
        }
        SEAM(pA + 4);
    }
    if (EN(7) && IN(2 + 5 * NLAY)) { RELAUNDER(); final_phase(C); }
#undef IN
#undef EN
#undef SEAM
}


#ifndef N_LAUNCH_SPLIT
#define N_LAUNCH_SPLIT 0
#endif
extern "C" void kernel_launch(void* const* d_in, const int* in_sizes, int n_in, void* d_out, int out_size, void* d_ws, size_t ws_size, hipStream_t stream) {
    static int grid = 0;
    if (grid == 0) {
        if (n_in != 16 || out_size != TOK * DM || ws_size < WS_END) { fprintf(stderr, "kernel_launch: unexpected shapes (n_in %d, out %d, ws %zu < %zu)\n", n_in, out_size, ws_size, (size_t)WS_END); grid = -1; return; }
        int dev = 0, cus = 0;
        if (hipGetDevice(&dev) != hipSuccess || hipDeviceGetAttribute(&cus, hipDeviceAttributeMultiprocessorCount, dev) != hipSuccess) { grid = -1; return; }
        if (hipFuncSetAttribute((const void*)fwd, hipFuncAttributeMaxDynamicSharedMemorySize, LDS_BYTES) != hipSuccess) { fprintf(stderr, "kernel_launch: hipFuncSetAttribute failed\n"); grid = -1; return; }
        int per_cu = 0;
        if (hipOccupancyMaxActiveBlocksPerMultiprocessor(&per_cu, (const void*)fwd, NWAVES * 64, LDS_BYTES) != hipSuccess || per_cu < 1) fprintf(stderr, "kernel_launch: occupancy query says %d blocks per CU\n", per_cu);
        (void)hipGetLastError();
        grid = cus;
        { pg8::StaticOrder S; bool fixed = true;
          for (int c = 0; c < grid && fixed; ++c) { S.init(TOK, NP, grid, c); pg8::Unit u0, u; if (!S.next(0, u0)) continue; for (int i = 1; S.next(i, u); ++i) if (u.pm != u0.pm) { fixed = false; break; } }
          if (!fixed) { fprintf(stderr, "kernel_launch: unit order does not keep a workgroup inside one row panel at grid %d; nothing launched\n", grid); grid = -1; return; } }
    }
    if (grid < 0) return;
    (void)hipMemsetAsync(d_ws, 0, CTL_BYTES, stream);
    Args a{};
    for (int i = 0; i < 16; ++i) a.in[i] = (const float*)d_in[i];
    a.out = (float*)d_out; a.ws = (unsigned char*)d_ws;
#if N_LAUNCH_SPLIT
    for (int ph = 0; ph < N_PHASES; ++ph) { a.ph_lo = ph; a.ph_hi = ph + 1; hipLaunchKernelGGL(fwd, dim3(grid), dim3(NWAVES * 64), LDS_BYTES, stream, a);
    }
#elif defined(REPEAT_LO)
    a.ph_lo = 0; a.ph_hi = REPEAT_HI; a.li = 0; hipLaunchKernelGGL(fwd, dim3(grid), dim3(NWAVES * 64), LDS_BYTES, stream, a);
    a.ph_lo = REPEAT_LO; a.ph_hi = N_PHASES; a.li = 1; hipLaunchKernelGGL(fwd, dim3(grid), dim3(NWAVES * 64), LDS_BYTES, stream, a);
#elif defined(REPEAT_PH)
    a.ph_lo = 0; a.ph_hi = REPEAT_PH + 1; a.li = 0; hipLaunchKernelGGL(fwd, dim3(grid), dim3(NWAVES * 64), LDS_BYTES, stream, a);
    a.ph_lo = REPEAT_PH; a.ph_hi = N_PHASES; a.li = 1; hipLaunchKernelGGL(fwd, dim3(grid), dim3(NWAVES * 64), LDS_BYTES, stream, a);
#else
    a.ph_lo = 0; a.ph_hi = N_PHASES; hipLaunchKernelGGL(fwd, dim3(grid), dim3(NWAVES * 64), LDS_BYTES, stream, a);
#endif
}
```

```cpp
#include <hip/hip_runtime.h>
#include <cstdio>
#include <cstdint>
#include <cmath>
namespace pg8 {
#define PG8_LAS __attribute__((address_space(3)))
typedef unsigned short bf16_t;
typedef short bf16x8 __attribute__((ext_vector_type(8)));
typedef float f32x4 __attribute__((ext_vector_type(4)));
typedef unsigned u32x4 __attribute__((ext_vector_type(4)));
constexpr int BM = 256, BK = 64, HALF = 128, HTB = HALF * BK * 2  , STAGE_BYTES = 8 * HTB, NXCD = 8, WGM = 8;

__host__ __device__ __forceinline__ int lds_byte(int r, int c) { const int st = (r >> 4) * 2 + (c >> 5), rr = r & 15, cc = c & 31, ob = rr * 64 + cc * 2; return st * 1024 + (ob ^ (((ob >> 9) & 1) << 5)); }
__host__ __device__ __forceinline__ void stage_rc(int b, int& R, int& C) { const int st = b / 1024, sb = b % 1024, swz = sb ^ (((sb >> 9) & 1) << 5); R = (st >> 1) * 16 + swz / 64; C = (st & 1) * 32 + (swz % 64) / 2; }
__host__ __device__ __forceinline__ int perm32(int rho) { const int n = rho >> 4, i = rho & 15; return 8 * (i >> 2) + 4 * n + (i & 3); }

struct Unit { int pm, pn; };
struct Gemm { const bf16_t* A; const bf16_t* Bt; int M, N, K; };

struct StaticOrder {
    int nM, nN, nwg, G, c, mix;
    __host__ __device__ void init(int M, int N, int G_, int c_) { nM = M / BM; nN = N / BM; nwg = nM * nN; G = G_; c = c_; mix = 0; }
    __host__ __device__ __forceinline__ bool next(int i, Unit& u) const {
        const long L = (long)i * G + c; if (L >= nwg) return false;
        int wgid = (int)L; { const int q = nwg / NXCD, r = nwg % NXCD, xcd = wgid % NXCD, off = wgid / NXCD; wgid = (xcd < r ? xcd * (q + 1) : r * (q + 1) + (xcd - r) * q) + off; }
        const int nig = WGM * nN, gid = wgid / nig, fm = gid * WGM, gsz = (nM - fm) < WGM ? (nM - fm) : WGM;
        u.pm = fm + ((wgid % nig) % gsz); u.pn = (wgid % nig) / gsz;
        if (mix) { const int h = u.pn / 56, i = u.pn - 56 * h, g7 = i / 7, j7 = i - 7 * g7;
            u.pn = (j7 & 1) ? 64 + 24 * h + 3 * g7 + (j7 >> 1) : 32 * h + 4 * g7 + (j7 >> 1); }
        return true;
    }
    __device__ __forceinline__ void a_ready(const Unit&) const {}
    __device__ __forceinline__ void done(const Unit&) const {}
};
typedef __bf16 bf16x2v __attribute__((ext_vector_type(2)));
typedef float f32x2v __attribute__((ext_vector_type(2)));
typedef unsigned u32x2 __attribute__((ext_vector_type(2)));
__device__ __forceinline__ unsigned cvt_pk_bf16(float lo, float hi) { f32x2v v = {lo, hi}; bf16x2v b = __builtin_convertvector(v, bf16x2v); return __builtin_bit_cast(unsigned, b); }
__device__ __forceinline__ float bflo(unsigned w) { return __uint_as_float(w << 16); }
__device__ __forceinline__ float bfhi(unsigned w) { return __uint_as_float(w & 0xffff0000u); }
__device__ __forceinline__ float sigmoidf_(float x) { return __builtin_amdgcn_rcpf(1.0f + __builtin_amdgcn_exp2f(-1.4426950408889634f * x)); }
__device__ __forceinline__ u32x4 pack8(const f32x4& v0, const f32x4& v1) { u32x4 w; w.x = cvt_pk_bf16(v0[0], v0[1]); w.y = cvt_pk_bf16(v0[2], v0[3]); w.z = cvt_pk_bf16(v1[0], v1[1]); w.w = cvt_pk_bf16(v1[2], v1[3]); return w; }

__device__ __forceinline__ unsigned q8_(float g) { return (unsigned)__builtin_fminf(g * 256.0f, 255.0f); }
__device__ __forceinline__ f32x2v gq2_(float a, float b) {
    const f32x2v x = {__builtin_amdgcn_fmed3f(a, -6.5f, 6.5f), __builtin_amdgcn_fmed3f(b, -6.5f, 6.5f)}; const f32x2v x2 = x * x;
    f32x2v p = x2 * (256.0f * 1.693533924e-10f) + (256.0f * -2.709654433e-08f);
    p = p * x2 + (256.0f * 1.777740446e-06f); p = p * x2 + (256.0f * -6.258466407e-05f); p = p * x2 + (256.0f * 1.324479733e-03f);
    p = p * x2 + (256.0f * -1.883604263e-02f); p = p * x2 + (256.0f * 2.483712057e-01f);
    const f32x2v y = p * x + 127.5f; return y + 12582912.0f;
}
__device__ __forceinline__ unsigned gpk4_(const f32x4& v) { const f32x2v a = gq2_(v[0], v[1]), b = gq2_(v[2], v[3]);
    return __builtin_amdgcn_perm(__float_as_uint(a.y), __float_as_uint(a.x), 0x0c0c0400u) | (__builtin_amdgcn_perm(__float_as_uint(b.y), __float_as_uint(b.x), 0x0c0c0400u) << 16); }
struct EpiProj {
    static constexpr bool PERM = true, AFTER_DRAIN = false, HAS_MID = false; static constexpr int MID0 = -1, MID1 = -1;
    bf16_t* O; int ldc; const float* rstd_g;
    PG8_LAS const float* rt;
    unsigned char* G8; int ldg, gate_pn0;
    __device__ __forceinline__ float row_scale(const Unit&, int row, int rloc) const { return rstd_g ? rstd_g[row] : rt[rloc]; }
    __device__ __forceinline__ void operator()(const f32x4 (&acc)[2][2][4][2], const Unit& u, int wr, int wc, int fr, int fq) const {
        const int rl0 = wr * 64 + fr, row0 = u.pm * BM + rl0;
        if (u.pn < gate_pn0) {
            const int col0 = u.pn * BM + wc * 32 + 8 * fq;
#pragma unroll
            for (int ai = 0; ai < 2; ++ai)
#pragma unroll
                for (int m = 0; m < 4; ++m) { const int row = row0 + ai * HALF + m * 16; const float rs = row_scale(u, row, rl0 + ai * HALF + m * 16); bf16_t* rowp = O + (size_t)row * ldc + col0;
#pragma unroll
                    for (int bj = 0; bj < 2; ++bj) { const f32x4 v0 = acc[ai][bj][m][0] * rs, v1 = acc[ai][bj][m][1] * rs; *(u32x4*)(rowp + bj * HALF) = pack8(v0, v1); } }
        } else {
            const int col0 = (u.pn - gate_pn0) * BM + wc * 32 + 8 * fq;
#pragma unroll
            for (int ai = 0; ai < 2; ++ai)
#pragma unroll
                for (int m = 0; m < 4; ++m) { const int row = row0 + ai * HALF + m * 16; const float rs = row_scale(u, row, rl0 + ai * HALF + m * 16); unsigned char* rowp = G8 + (size_t)row * ldg + col0;
#pragma unroll
                    for (int bj = 0; bj < 2; ++bj) { const f32x4 v0 = acc[ai][bj][m][0] * rs, v1 = acc[ai][bj][m][1] * rs; u32x2 w;
                        w.x = gpk4_(v0); w.y = gpk4_(v1);
                        *(u32x2*)(rowp + bj * HALF) = w; } }
        }
    }
};
__device__ __forceinline__ int perm16(int k) { return 8 * ((k >> 2) & 1) + 4 * (k >> 3) + (k & 3); }
__device__ __forceinline__ float ub_(unsigned w, int k) { return (float)((w >> (8 * k)) & 0xffu) + 0.5f; }
struct EpiUpF {
    static constexpr bool PERM = true, AFTER_DRAIN = false, HAS_MID = true; static constexpr int MID0 = 32, MID1 = 64;
    const unsigned char* G; int ldg, gstride; bf16_t* UB; int ldu;
    __device__ __forceinline__ void mid(f32x4 (&acc)[2][2][4][2], const Unit& u, bool second, int wr, int wc, int fr, int fq) const {
        const __amdgpu_buffer_rsrc_t rs = __builtin_amdgcn_make_buffer_rsrc((void*)G, 0, 0x7fffffff, 0x00020000);
        const int voff = (u.pm * BM + wr * 64 + fr) * ldg + u.pn * BM + wc * 32 + 8 * fq; const int sbase = second ? gstride : 0;
#pragma unroll
        for (int ai = 0; ai < 2; ++ai) {
            u32x2 ga[4][2], gb[4][2];
#pragma unroll
            for (int m = 0; m < 4; ++m)
#pragma unroll
                for (int bj = 0; bj < 2; ++bj) { const int so = sbase + (ai * HALF + m * 16) * ldg + bj * HALF;
                    ga[m][bj] = __builtin_amdgcn_raw_buffer_load_b64(rs, voff, so, 0); gb[m][bj] = __builtin_amdgcn_raw_buffer_load_b64(rs, voff, so + gstride, 0); }
#pragma unroll
            for (int m = 0; m < 4; ++m)
#pragma unroll
                for (int bj = 0; bj < 2; ++bj) { const u32x2 a = ga[m][bj], b = gb[m][bj];
                    const f32x4 r0 = {ub_(a.x, 0) * __builtin_amdgcn_rcpf(ub_(b.x, 0)), ub_(a.x, 1) * __builtin_amdgcn_rcpf(ub_(b.x, 1)), ub_(a.x, 2) * __builtin_amdgcn_rcpf(ub_(b.x, 2)), ub_(a.x, 3) * __builtin_amdgcn_rcpf(ub_(b.x, 3))};
                    acc[ai][bj][m][0] = acc[ai][bj][m][0] * r0;
                    const f32x4 r1 = {ub_(a.y, 0) * __builtin_amdgcn_rcpf(ub_(b.y, 0)), ub_(a.y, 1) * __builtin_amdgcn_rcpf(ub_(b.y, 1)), ub_(a.y, 2) * __builtin_amdgcn_rcpf(ub_(b.y, 2)), ub_(a.y, 3) * __builtin_amdgcn_rcpf(ub_(b.y, 3))};
                    acc[ai][bj][m][1] = acc[ai][bj][m][1] * r1; }
            asm volatile("" ::: "memory"); }
    }
    __device__ __forceinline__ void operator()(const f32x4 (&acc)[2][2][4][2], const Unit& u, int wr, int wc, int fr, int fq) const {
        const __amdgpu_buffer_rsrc_t rs = __builtin_amdgcn_make_buffer_rsrc((void*)G, 0, 0x7fffffff, 0x00020000);
        const int row0 = u.pm * BM + wr * 64 + fr, col0 = u.pn * BM + wc * 32 + 8 * fq; const int voff = row0 * ldg + col0;
#pragma unroll
        for (int ai = 0; ai < 2; ++ai) {
            u32x2 gwv[4][2];
#pragma unroll
            for (int m = 0; m < 4; ++m)
#pragma unroll
                for (int bj = 0; bj < 2; ++bj) gwv[m][bj] = __builtin_amdgcn_raw_buffer_load_b64(rs, voff, 2 * gstride + (ai * HALF + m * 16) * ldg + bj * HALF, 0);
#pragma unroll
            for (int m = 0; m < 4; ++m) { const int row = row0 + ai * HALF + m * 16;
#pragma unroll
                for (int bj = 0; bj < 2; ++bj) { const int col = col0 + bj * HALF; const u32x2 gw = gwv[m][bj]; const float k = 1.0f / 256.0f;
                    const f32x4 g0 = {ub_(gw.x, 0) * k, ub_(gw.x, 1) * k, ub_(gw.x, 2) * k, ub_(gw.x, 3) * k}, g1 = {ub_(gw.y, 0) * k, ub_(gw.y, 1) * k, ub_(gw.y, 2) * k, ub_(gw.y, 3) * k};
                    *(u32x4*)(UB + (size_t)row * ldu + col) = pack8(acc[ai][bj][m][0] * g0, acc[ai][bj][m][1] * g1); } }
            asm volatile("" ::: "memory"); }
    }
};
struct EpiOut {
    static constexpr bool PERM = true, AFTER_DRAIN = false, HAS_MID = false; static constexpr int MID0 = -1, MID1 = -1;
    bf16_t* xb; float* ssqp; int ldc;
    __device__ __forceinline__ void operator()(const f32x4 (&acc)[2][2][4][2], const Unit& u, int wr, int wc, int fr, int fq) const {
        const int row0 = u.pm * BM + wr * 64 + fr, col0 = u.pn * BM + wc * 32 + 8 * fq;
#pragma unroll
        for (int ai = 0; ai < 2; ++ai)
#pragma unroll
            for (int m = 0; m < 4; ++m) { const int row = row0 + ai * HALF + m * 16; float ss = 0.f;
#pragma unroll
                for (int bj = 0; bj < 2; ++bj) { const size_t off = (size_t)row * ldc + col0 + bj * HALF; const u32x4 xo = *(const u32x4*)(xb + off);
                    const f32x4 v0 = (f32x4){bflo(xo.x), bfhi(xo.x), bflo(xo.y), bfhi(xo.y)} + acc[ai][bj][m][0], v1 = (f32x4){bflo(xo.z), bfhi(xo.z), bflo(xo.w), bfhi(xo.w)} + acc[ai][bj][m][1];
                    *(u32x4*)(xb + off) = pack8(v0, v1);
                    ss += (v0[0] * v0[0] + v0[1] * v0[1]) + (v0[2] * v0[2] + v0[3] * v0[3]) + (v1[0] * v1[0] + v1[1] * v1[1]) + (v1[2] * v1[2] + v1[3] * v1[3]); }
                ss += __shfl_xor(ss, 16); ss += __shfl_xor(ss, 32);
                if (fq == 0) ssqp[(size_t)row * 64 + u.pn * 4 + wc] = ss; }
    }
};

template <class Epi, class Sched, bool ALIGN_EPI = false, bool SP2 = false>
__device__ __forceinline__ void gemm_phase(PG8_LAS unsigned char* lds, const Gemm g, const Sched& S, const Epi& E) {
    int tid = threadIdx.x; asm volatile("" : "+v"(tid)); const int wid = __builtin_amdgcn_readfirstlane(tid >> 6), lane = tid & 63, wr = wid >> 2, wc = wid & 3, fr = lane & 15, fq = lane >> 4;
    const int K = g.K, nt = K / BK;
    unsigned voffA[2], voffB[2];
#pragma unroll
    for (int i = 0; i < 2; ++i) { int R, C; stage_rc(tid * 16 + i * 8192, R, C); const int Rb = Epi::PERM ? ((R & ~31) + perm32(R & 31)) : R;
        voffA[i] = (unsigned)(R * K + C) * 2u; voffB[i] = (unsigned)(Rb * K + C) * 2u; }
    const size_t kstep = (size_t)(BK * 2);
    const size_t hstep = (size_t)HALF * K * 2;
    const size_t tstep = 2 * hstep;
    const unsigned ldsw = (unsigned)wid * 1024u;
    const int aoff = lds_byte(wr * 64 + fr, fq * 8), boff = lds_byte(wc * 32 + fr, fq * 8);
#define PG8_SA(b, h) (((b) * 2 + (h)) * HTB)
#define PG8_SB(b, h) ((4 + (b) * 2 + (h)) * HTB)
#define PG8_STAGE(bufoff, gbase, voff) do { _Pragma("unroll") for (int _i = 0; _i < 2; ++_i) \
        __builtin_amdgcn_global_load_lds((const unsigned*)((const char*)(gbase) + (voff)[_i]), (PG8_LAS unsigned*)(lds + (bufoff) + ldsw + _i * 8192), 16, 0, PG8_AAUX); } while (0)
#ifndef PG8_BAUX
#define PG8_BAUX 0
#endif
#ifndef PG8_AAUX
#define PG8_AAUX 0
#endif
#define PG8_STAGEB(bufoff, gbase, voff) do { _Pragma("unroll") for (int _i = 0; _i < 2; ++_i) \
        __builtin_amdgcn_global_load_lds((const unsigned*)((const char*)(gbase) + (voff)[_i]), (PG8_LAS unsigned*)(lds + (bufoff) + ldsw + _i * 8192), 16, 0, PG8_BAUX); } while (0)
#define PG8_LDA(dst, b, h) do { _Pragma("unroll") for (int m = 0; m < 4; ++m) _Pragma("unroll") for (int k = 0; k < 2; ++k) dst[m][k] = *(const PG8_LAS bf16x8*)(lds + PG8_SA(b, h) + aoff + m * 2048 + k * 1024); } while (0)
#define PG8_LDB(dst, b, h) do { _Pragma("unroll") for (int n = 0; n < 2; ++n) _Pragma("unroll") for (int k = 0; k < 2; ++k) dst[n][k] = *(const PG8_LAS bf16x8*)(lds + PG8_SB(b, h) + boff + n * 2048 + k * 1024); } while (0)
#define PG8_MMA(ai, bj, At, Bt) do { __builtin_amdgcn_s_setprio(1); _Pragma("unroll") for (int m = 0; m < 4; ++m) _Pragma("unroll") for (int n = 0; n < 2; ++n) _Pragma("unroll") for (int k = 0; k < 2; ++k) \
        acc[ai][bj][m][n] = __builtin_amdgcn_mfma_f32_16x16x32_bf16(Bt[n][k], At[m][k], acc[ai][bj][m][n], 0, 0, 0); __builtin_amdgcn_s_setprio(0); } while (0)
#define PG8_WAIT_V(n) asm volatile("s_waitcnt vmcnt(" #n ")" ::: "memory")
#define PG8_WAIT_L(n) asm volatile("s_waitcnt lgkmcnt(" #n ")" ::: "memory")
#define PG8_BAR __builtin_amdgcn_s_barrier()
#define PG8_SCHED __builtin_amdgcn_sched_barrier(0)
    Unit cur, nxt; int ui = 0;
    if (!S.next(0, cur)) return;
    f32x4 acc[2][2][4][2];
#pragma unroll
    for (int a = 0; a < 2; ++a)
#pragma unroll
        for (int b = 0; b < 2; ++b)
#pragma unroll
            for (int m = 0; m < 4; ++m)
#pragma unroll
                for (int n = 0; n < 2; ++n) acc[a][b][m][n] = (f32x4){0.f, 0.f, 0.f, 0.f};
    bf16x8 At[4][2], B0[2][2], B1[2][2];
    const char* cA = (const char*)g.A + (size_t)cur.pm * tstep; const char* cB = (const char*)g.Bt + (size_t)cur.pn * tstep;
    S.a_ready(cur);
    if constexpr (SP2) {
        PG8_STAGEB(PG8_SB(0, 0), cB, voffB); PG8_STAGEB(PG8_SB(0, 1), cB + hstep, voffB); PG8_STAGE(PG8_SA(0, 0), cA, voffA); PG8_STAGE(PG8_SA(0, 1), cA + hstep, voffA);
        if (wr == 1) PG8_BAR;
        PG8_WAIT_V(2); PG8_BAR;
        PG8_STAGEB(PG8_SB(1, 0), cB + kstep, voffB); PG8_STAGE(PG8_SA(1, 0), cA + kstep, voffA); PG8_STAGEB(PG8_SB(1, 1), cB + hstep + kstep, voffB);
        PG8_WAIT_V(6); PG8_BAR;
    } else {
        PG8_STAGEB(PG8_SB(0, 0), cB, voffB); PG8_STAGE(PG8_SA(0, 0), cA, voffA); PG8_STAGEB(PG8_SB(0, 1), cB + hstep, voffB); PG8_STAGE(PG8_SA(0, 1), cA + hstep, voffA);
        if (wr == 1) PG8_BAR;
        PG8_WAIT_V(4); PG8_BAR;
        PG8_STAGEB(PG8_SB(1, 0), cB + kstep, voffB); PG8_STAGE(PG8_SA(1, 0), cA + kstep, voffA); PG8_STAGEB(PG8_SB(1, 1), cB + hstep + kstep, voffB);
        PG8_WAIT_V(6); PG8_BAR;
    }
    for (;;) {
        const bool has_next = S.next(ui + 1, nxt);
        const char* nA = has_next ? (const char*)g.A + (size_t)nxt.pm * tstep : cA; const char* nB = has_next ? (const char*)g.Bt + (size_t)nxt.pn * tstep : cB;
        for (int t = 0; t < nt; t += 2) {
            const bool last = (t == nt - 2);
            const char* a1 = cA + (size_t)(t + 1) * kstep;
            const char* a2 = last ? nA : cA + (size_t)(t + 2) * kstep; const char* b2 = last ? nB : cB + (size_t)(t + 2) * kstep;
            const char* a3 = a2 + kstep; const char* b3 = b2 + kstep;
            if (last && has_next) S.a_ready(nxt);
            if constexpr (Epi::HAS_MID) { if (t == Epi::MID0 || t == Epi::MID1) E.mid(acc, cur, t == Epi::MID1, wr, wc, fr, fq); }
            if constexpr (SP2) {
            PG8_LDB(B0, 0, 0); PG8_LDB(B1, 0, 1); PG8_SCHED; PG8_LDA(At, 0, 0); PG8_STAGE(PG8_SA(1, 1), a1 + hstep, voffA);
            PG8_WAIT_V(8); PG8_WAIT_L(0); PG8_BAR; PG8_MMA(0, 0, At, B0); PG8_MMA(0, 1, At, B1); PG8_BAR; PG8_SCHED;
            PG8_LDA(At, 0, 1); PG8_STAGEB(PG8_SB(0, 0), b2, voffB); PG8_STAGEB(PG8_SB(0, 1), b2 + hstep, voffB); PG8_STAGE(PG8_SA(0, 0), a2, voffA);
            PG8_WAIT_V(8); PG8_WAIT_L(0); PG8_BAR; PG8_MMA(1, 0, At, B0); PG8_MMA(1, 1, At, B1); PG8_BAR; PG8_SCHED;
            PG8_LDB(B0, 1, 0); PG8_LDB(B1, 1, 1); PG8_SCHED; PG8_LDA(At, 1, 0); PG8_STAGE(PG8_SA(0, 1), a2 + hstep, voffA);
            PG8_WAIT_V(8); PG8_WAIT_L(0); PG8_BAR; PG8_MMA(0, 0, At, B0); PG8_MMA(0, 1, At, B1); PG8_BAR; PG8_SCHED;
            PG8_LDA(At, 1, 1); PG8_STAGEB(PG8_SB(1, 0), b3, voffB); PG8_STAGEB(PG8_SB(1, 1), b3 + hstep, voffB); PG8_STAGE(PG8_SA(1, 0), a3, voffA);
            PG8_WAIT_V(8); PG8_WAIT_L(0); PG8_BAR; PG8_MMA(1, 0, At, B0); PG8_MMA(1, 1, At, B1); PG8_BAR; PG8_SCHED;
            } else {
            PG8_LDB(B0, 0, 0); PG8_SCHED; PG8_LDA(At, 0, 0); PG8_STAGE(PG8_SA(1, 1), a1 + hstep, voffA);
            PG8_WAIT_L(8); PG8_BAR; PG8_WAIT_L(0); PG8_MMA(0, 0, At, B0); PG8_BAR; PG8_SCHED;
            PG8_LDB(B1, 0, 1); PG8_STAGEB(PG8_SB(0, 0), b2, voffB);
            PG8_BAR; PG8_WAIT_L(0); PG8_MMA(0, 1, At, B1); PG8_BAR;
            PG8_LDA(At, 0, 1); PG8_STAGE(PG8_SA(0, 0), a2, voffA);
            PG8_BAR; PG8_WAIT_L(0); PG8_MMA(1, 0, At, B0); PG8_BAR; PG8_SCHED;
            PG8_STAGEB(PG8_SB(0, 1), b2 + hstep, voffB);
            PG8_WAIT_V(6); PG8_BAR; PG8_MMA(1, 1, At, B1); PG8_BAR;
            PG8_LDB(B0, 1, 0); PG8_SCHED; PG8_LDA(At, 1, 0); PG8_STAGE(PG8_SA(0, 1), a2 + hstep, voffA);
            PG8_WAIT_L(8); PG8_BAR; PG8_WAIT_L(0); PG8_MMA(0, 0, At, B0); PG8_BAR; PG8_SCHED;
            PG8_LDB(B1, 1, 1); PG8_STAGEB(PG8_SB(1, 0), b3, voffB);
            PG8_BAR; PG8_WAIT_L(0); PG8_MMA(0, 1, At, B1); PG8_BAR;
            PG8_LDA(At, 1, 1); PG8_STAGE(PG8_SA(1, 0), a3, voffA);
            PG8_BAR; PG8_WAIT_L(0); PG8_MMA(1, 0, At, B0); PG8_BAR; PG8_SCHED;
            PG8_STAGEB(PG8_SB(1, 1), b3 + hstep, voffB);
            PG8_WAIT_V(6); PG8_BAR; PG8_MMA(1, 1, At, B1); PG8_BAR;
            }
        }
        if constexpr (ALIGN_EPI) { if (wr == 0) PG8_BAR; }
        if constexpr (!Epi::AFTER_DRAIN) { E(acc, cur, wr, wc, fr, fq); S.done(cur); }
        if (!has_next) break;
#pragma unroll
        for (int a = 0; a < 2; ++a)
#pragma unroll
            for (int b = 0; b < 2; ++b)
#pragma unroll
                for (int m = 0; m < 4; ++m)
#pragma unroll
                    for (int n = 0; n < 2; ++n) acc[a][b][m][n] = (f32x4){0.f, 0.f, 0.f, 0.f};
        cur = nxt; cA = nA; cB = nB; ++ui;
        if constexpr (ALIGN_EPI) { if (wr == 1) PG8_BAR; }
    }
    PG8_WAIT_V(0);
    if constexpr (!ALIGN_EPI) { if (wr == 0) PG8_BAR; }
    PG8_BAR;
    if constexpr (Epi::AFTER_DRAIN) { E.fused(acc, cur, wr, wc, fr, fq, lds, wid, lane); S.done(cur); }
#undef PG8_SA
#undef PG8_SB
#undef PG8_STAGE
#undef PG8_STAGEB
#undef PG8_LDA
#undef PG8_LDB
#undef PG8_MMA
#undef PG8_WAIT_V
#undef PG8_WAIT_L
#undef PG8_BAR
#undef PG8_SCHED
}
}

#define LAS __attribute__((address_space(3)))
typedef unsigned short bf16;
typedef short bf16x8 __attribute__((ext_vector_type(8)));
typedef float f32x4 __attribute__((ext_vector_type(4)));
typedef float f32x16 __attribute__((ext_vector_type(16)));
typedef unsigned u32x4 __attribute__((ext_vector_type(4)));
typedef unsigned u32x2 __attribute__((ext_vector_type(2)));
using pg8::cvt_pk_bf16; using pg8::bflo; using pg8::bfhi; using pg8::sigmoidf_; using pg8::perm16;

constexpr int DM = 4096, NBAT = 4, SEQ = 2048, NLAY = 4, TOK = NBAT * SEQ, HD = 128;
constexpr int NP = 28672;
constexpr int C_AH = 0, C_AB = 2048, C_AC = 4096, C_AZ = 6144, C_NQ = 8192, C_KV = 10240, C_NZ = 13312, C_XQ = 15360, C_XZ = 15872, C_MG = 16384;
constexpr int INW = 28720, S_NG = 13312, S_NZ = 13360;
constexpr float EPS = 1e-6f;
constexpr int NWAVES = 8;

constexpr size_t CTL_BYTES = 1u << 20;
constexpr size_t WS_WIN = CTL_BYTES;
constexpr int YK = 4608;
constexpr size_t WS_WUP = WS_WIN + (size_t)NLAY * NP * DM * 2;
constexpr size_t WS_WO = WS_WUP + (size_t)NLAY * DM * YK * 2;
constexpr size_t WS_WMKV = WS_WO + (size_t)NLAY * DM * DM * 2;
constexpr size_t WS_W1 = WS_WMKV + (size_t)4096 * DM * 2;
constexpr size_t WS_W2 = WS_W1 + (size_t)NLAY * 2 * 128 * 4096 * 2;
constexpr size_t WS_PB = WS_W2 + (size_t)NLAY * 2 * 128 * 128 * 2;
constexpr size_t WS_COS = WS_PB + 4096;
constexpr size_t WS_SIN = WS_COS + (size_t)SEQ * 64 * 4;
constexpr size_t WS_XB = WS_SIN + (size_t)SEQ * 64 * 4;
constexpr size_t WS_MEMB = WS_XB + (size_t)TOK * DM * 2;
constexpr size_t WS_RSTDM = WS_MEMB + (size_t)1024 * DM * 2;
constexpr size_t WS_SSQP = WS_RSTDM + 4096;
constexpr size_t WS_RSTD = WS_SSQP + (size_t)TOK * 64 * 4;
constexpr size_t WS_P = WS_RSTD + (size_t)TOK * 4;
constexpr size_t WS_MEMK = WS_P + (size_t)TOK * NP * 2;
constexpr size_t WS_MEMVT = WS_MEMK + (size_t)1024 * 4096 * 2;
constexpr size_t WS_KR = WS_MEMVT + (size_t)NLAY * 16 * 256 * 128 * 2;
constexpr size_t WS_VT = WS_KR + (size_t)2 * 16 * SEQ * 128 * 2;
constexpr size_t WS_KC = WS_VT + (size_t)2 * 16 * SEQ * 128 * 2;
constexpr size_t WS_VTC = WS_KC + (size_t)16 * 128 * 128 * 2;
constexpr size_t WS_Y = WS_VTC + (size_t)16 * 128 * 128 * 2;
constexpr size_t WS_UB = WS_Y + (size_t)TOK * YK * 2;
constexpr size_t WS_MEMK2 = WS_UB + (size_t)TOK * DM * 2;
constexpr size_t WS_WG = WS_MEMK2 + (size_t)NLAY * 16 * 256 * 128 * 2;
constexpr size_t WS_NG = WS_WG + (size_t)NLAY * 64 * DM * 2;
constexpr size_t WS_TSC = WS_NG + (size_t)TOK * 48 * 4;
constexpr size_t WS_G8 = WS_TSC + (size_t)320 * 8 * 32 * 64 * 4;
constexpr size_t WS_END = WS_G8 + (size_t)TOK * 3 * DM;
constexpr int CW_Q = 12288;
constexpr int CW_BAR = 4096;

constexpr int RING_BYTES = 131072, MISC_OFF = RING_BYTES + 320, RT_OFF = RING_BYTES + 2048  , LDS_BYTES = 147456;
constexpr int A_KB0 = 0, A_KB1 = 16384, A_VB0 = 32768, A_VB1 = 49152, A_IMPW = 65536;
constexpr int A_IMPS = A_IMPW + 8 * 32 * 33 * 4, A_SELM = A_IMPS + 64 * 33 * 4, A_END = A_SELM + 256;
static_assert(A_END <= RING_BYTES, "attention LDS map");

#define LDS_WAIT() asm volatile("s_waitcnt lgkmcnt(0)" ::: "memory")
__device__ __forceinline__ int bx_now() { int b = blockIdx.x; asm volatile("" : "+s"(b)); return b; }
__device__ __forceinline__ int tid_now() { int t = threadIdx.x; asm volatile("" : "+v"(t)); return t; }
__device__ __forceinline__ float bf2f(bf16 v) { return __uint_as_float(((unsigned)v) << 16); }
__device__ __forceinline__ bf16 f2bf(float f) { return (bf16)(cvt_pk_bf16(f, 0.f) & 0xffffu); }
__device__ __forceinline__ float wave_sum(float v) {
#pragma unroll
    for (int o = 1; o < 64; o <<= 1) v += __shfl_xor(v, o);
    return v;
}
__device__ __forceinline__ float siluf_(float x) { return x * sigmoidf_(x); }

#define XB_TMO      128
#define XB_XCNT(j)  (256  + 64 * (j))
#define XB_XSUB(j)  (1280 + 64 * (j))
#define XB_XGEN(j)  (2304 + 64 * (j))
#define XB_TOP      3328
#define XB_TOPGEN   3392
#define XCD_BAR_WORDS 3456
#define XB_SPIN_CAP (1u << 22)
__device__ __forceinline__ unsigned xb_ld(unsigned* p)              { return __hip_atomic_load(p, __ATOMIC_RELAXED, __HIP_MEMORY_SCOPE_AGENT); }
__device__ __forceinline__ unsigned xb_add(unsigned* p, unsigned v) { return __hip_atomic_fetch_add(p, v, __ATOMIC_RELAXED, __HIP_MEMORY_SCOPE_AGENT); }
__device__ __forceinline__ unsigned xb_xcc_id() { return (unsigned)__builtin_amdgcn_s_getreg((3 << 11) | 20) & 0xFu; }
#define XB_SPIN(cond, bar) do { unsigned _sp = 0; while (cond) { __builtin_amdgcn_s_sleep(1); \
    if ((++_sp & 255u) == 0u) { if (xb_ld(&(bar)[XB_TMO])) break; if (_sp > XB_SPIN_CAP) { atomicAdd(&(bar)[XB_TMO], 1u); break; } } } } while (0)
struct XcdBarrier { unsigned* bar; unsigned x; volatile LAS unsigned* st; };
__device__ __forceinline__ XcdBarrier xcd_barrier_post(unsigned* bar, volatile LAS unsigned* st) {
    XcdBarrier b; b.bar = bar; b.x = xb_xcc_id(); b.st = st;
    if (threadIdx.x == 0) (void)xb_add(&bar[XB_XCNT(b.x)], 1u);
    return b;
}
__device__ __forceinline__ void xcd_barrier_complete(unsigned* bar, unsigned x, unsigned& nloc, unsigned& nx) {
    const unsigned G = gridDim.x * gridDim.y * gridDim.z;
    unsigned sum, cnt, mine, sp = 0u;
    for (;;) {
        sum = 0u; cnt = 0u; mine = 0u;
#pragma unroll
        for (unsigned j = 0; j < 16; ++j) { const unsigned c = xb_ld(&bar[XB_XCNT(j)]); sum += c; cnt += (c > 0u) ? 1u : 0u; mine = (j == x) ? c : mine; }
        if (sum == G) break;
        __builtin_amdgcn_s_sleep(1);
        if ((++sp & 255u) == 0u) { if (xb_ld(&bar[XB_TMO])) break; if (sp > XB_SPIN_CAP) { atomicAdd(&bar[XB_TMO], 1u); break; } }
    }
    nloc = mine > 0u ? mine : 1u; nx = cnt > 0u ? cnt : 1u;
}
__device__ __forceinline__ void xcd_barrier(const XcdBarrier& b) {
    asm volatile("s_waitcnt vmcnt(0)" ::: "memory");
    __syncthreads();
    if (threadIdx.x == 0) {
        unsigned* bar = b.bar;
        __builtin_amdgcn_s_waitcnt(0);
        unsigned nloc = b.st[0], nx = b.st[1];
        if (nloc == 0u) { xcd_barrier_complete(bar, b.x, nloc, nx); b.st[0] = nloc; b.st[1] = nx; }
        const unsigned old = xb_add(&bar[XB_XSUB(b.x)], 1u);
        const unsigned gen = old / nloc;
        if (old + 1u == (gen + 1u) * nloc) {
            __builtin_amdgcn_fence(__ATOMIC_RELEASE, "agent");
            asm volatile("s_waitcnt vmcnt(0)" ::: "memory");
            const unsigned og = xb_add(&bar[XB_TOP], 1u);
            const unsigned tg = og / nx;
            if (og + 1u == (tg + 1u) * nx) xb_add(&bar[XB_TOPGEN], 1u);
            else XB_SPIN(xb_ld(&bar[XB_TOPGEN]) == tg, bar);
            __builtin_amdgcn_fence(__ATOMIC_ACQUIRE, "agent");
            xb_add(&bar[XB_XGEN(b.x)], 1u);
            asm volatile("s_waitcnt vmcnt(0)" ::: "memory");
        } else {
            XB_SPIN(xb_ld(&bar[XB_XGEN(b.x)]) == gen, bar);
            __builtin_amdgcn_fence(__ATOMIC_ACQUIRE, "agent");
            asm volatile("s_waitcnt vmcnt(0)" ::: "memory");
        }
    }
    __syncthreads();
}

struct Ctx {
    const float *x, *mem, *norm_g, *w_in, *conv_w, *conv_b, *cmp_pos, *cmp_w1, *cmp_w2, *mem_norm_g, *w_mem_kv, *w_up_a, *w_up_b, *w_up_x, *w_out, *final_g;
    float* out;
    unsigned char* ws;
    int G, vcu;
    __device__ __forceinline__ bf16* Win_t() const { return (bf16*)(ws + WS_WIN); }
    __device__ __forceinline__ bf16* Wup_t() const { return (bf16*)(ws + WS_WUP); }
    __device__ __forceinline__ bf16* Wo_t() const { return (bf16*)(ws + WS_WO); }
    __device__ __forceinline__ bf16* Wmkv_t() const { return (bf16*)(ws + WS_WMKV); }
    __device__ __forceinline__ bf16* W1_t() const { return (bf16*)(ws + WS_W1); }
    __device__ __forceinline__ bf16* W2_t() const { return (bf16*)(ws + WS_W2); }
    __device__ __forceinline__ float* pb() const { return (float*)(ws + WS_PB); }
    __device__ __forceinline__ float* cost() const { return (float*)(ws + WS_COS); }
    __device__ __forceinline__ float* sint() const { return (float*)(ws + WS_SIN); }
    __device__ __forceinline__ float* rstdm() const { return (float*)(ws + WS_RSTDM); }
    __device__ __forceinline__ float* ssqp() const { return (float*)(ws + WS_SSQP); }
    __device__ __forceinline__ float* rstd() const { return (float*)(ws + WS_RSTD); }
    __device__ __forceinline__ bf16* xb() const { return (bf16*)(ws + WS_XB); }
    __device__ __forceinline__ bf16* memb() const { return (bf16*)(ws + WS_MEMB); }
    __device__ __forceinline__ bf16* P() const { return (bf16*)(ws + WS_P); }
    __device__ __forceinline__ bf16* MKV() const { return (bf16*)(ws + WS_MEMK); }
    __device__ __forceinline__ bf16* memK() const { return (bf16*)(ws + WS_MEMK2); }
    __device__ __forceinline__ bf16* memVt() const { return (bf16*)(ws + WS_MEMVT); }
    __device__ __forceinline__ bf16* Kr() const { return (bf16*)(ws + WS_KR); }
    __device__ __forceinline__ bf16* Vt() const { return (bf16*)(ws + WS_VT); }
    __device__ __forceinline__ bf16* Kc() const { return (bf16*)(ws + WS_KC); }
    __device__ __forceinline__ bf16* Vtc() const { return (bf16*)(ws + WS_VTC); }
    __device__ __forceinline__ bf16* Y() const { return (bf16*)(ws + WS_Y); }
    __device__ __forceinline__ bf16* UB() const { return (bf16*)(ws + WS_UB); }
    __device__ __forceinline__ unsigned* tsc() const { return (unsigned*)(ws + WS_TSC); }
    __device__ __forceinline__ bf16* Wg_t() const { return (bf16*)(ws + WS_WG); }
    __device__ __forceinline__ float* ng() const { return (float*)(ws + WS_NG); }
    __device__ __forceinline__ unsigned char* G8() const { return ws + WS_G8; }
};

struct TrJob { const float* W; const float* gs; bf16* WT; int ldw, k0, ns, nvalid, ldk, nd; };
struct TrRegs { f32x4 v[8]; f32x4 g0, g1; };
__device__ __forceinline__ void tr_load(TrRegs& R, const TrJob& j, int lane) {
    const int col4 = (lane & 7) * 4, r0 = lane >> 3;
#pragma unroll
    for (int i = 0; i < 8; ++i) { f32x4 v = {0.f, 0.f, 0.f, 0.f}; if (col4 < j.nvalid) v = *(const f32x4*)(j.W + (size_t)(j.k0 + 8 * i + r0) * j.ldw + j.ns + col4); R.v[i] = v; }
    R.g0 = (f32x4){1.f, 1.f, 1.f, 1.f}; R.g1 = R.g0;
    if (j.gs) { R.g0 = *(const f32x4*)(j.gs + j.k0 + 8 * (lane & 7)); R.g1 = *(const f32x4*)(j.gs + j.k0 + 8 * (lane & 7) + 4); }
}
__device__ __forceinline__ void tr_store(const TrRegs& R, const TrJob& j, LAS float* scr, int lane) {
    const int col4 = (lane & 7) * 4, r0 = lane >> 3;
#pragma unroll
    for (int i = 0; i < 8; ++i) { LAS float* d = scr + (8 * i + r0) * 33 + col4; d[0] = R.v[i][0]; d[1] = R.v[i][1]; d[2] = R.v[i][2]; d[3] = R.v[i][3]; }
    LDS_WAIT();
    const int c = lane & 7;
#pragma unroll
    for (int jj = 0; jj < 4; ++jj) { const int n = (lane >> 3) + 8 * jj; const LAS float* s = scr + (8 * c) * 33 + n;
        u32x4 o; o.x = cvt_pk_bf16(s[0 * 33] * R.g0[0], s[1 * 33] * R.g0[1]); o.y = cvt_pk_bf16(s[2 * 33] * R.g0[2], s[3 * 33] * R.g0[3]); o.z = cvt_pk_bf16(s[4 * 33] * R.g1[0], s[5 * 33] * R.g1[1]); o.w = cvt_pk_bf16(s[6 * 33] * R.g1[2], s[7 * 33] * R.g1[3]);
        *(u32x4*)(j.WT + (size_t)(j.nd + n) * j.ldk + j.k0 + 8 * c) = o; }
    LDS_WAIT();
}
constexpr int IT_IN1 = 64 * 416, IT_IN2 = 64 * 480, IT_ING = 64 * 2, IT_UA = 32 * 128, IT_UX = 8 * 128, IT_O = 64 * 128, IT_MKV = 64 * 32, IT_W1 = 64 * 4, IT_W2 = 2 * 4;
constexpr int IT_LAYER = IT_IN1 + IT_IN2 + IT_ING + 2 * IT_UA + IT_UX + IT_O + 2 * IT_W1 + 2 * IT_W2;
constexpr int TR_ITEMS = NLAY * IT_LAYER, TRCH = 16;
__device__ __forceinline__ TrJob tr_decode(const Ctx& C, int it) {
    TrJob j; const int l = it / IT_LAYER; int r = it - l * IT_LAYER; j.gs = nullptr; j.nvalid = 32;
    if (r < IT_IN1 + IT_IN2 + IT_ING) { j.W = C.w_in + (size_t)l * DM * INW; j.ldw = INW; j.gs = C.norm_g + l * DM; j.WT = C.Win_t() + (size_t)l * NP * DM; j.ldk = DM;
        if (r < IT_IN1) { j.k0 = 64 * (r / 416); j.ns = 32 * (r % 416); j.nd = j.ns; return j; } r -= IT_IN1;
        if (r < IT_IN2) { j.k0 = 64 * (r / 480); j.ns = S_NZ + 32 * (r % 480); j.nd = C_NZ + 32 * (r % 480); return j; } r -= IT_IN2;
        j.k0 = 64 * (r >> 1); j.ns = S_NG + 32 * (r & 1); j.nvalid = (r & 1) ? 16 : 32; j.WT = C.Wg_t() + (size_t)l * 64 * DM; j.nd = 32 * (r & 1); return j; }
    r -= IT_IN1 + IT_IN2 + IT_ING;
    if (r < IT_UA) { j.W = C.w_up_a + (size_t)l * 2048 * DM; j.ldw = DM; j.k0 = 64 * (r / 128); j.ns = 32 * (r % 128); j.WT = C.Wup_t() + (size_t)l * DM * YK; j.ldk = YK; j.nd = j.ns; return j; } r -= IT_UA;
    if (r < IT_UA) { j.W = C.w_up_b + (size_t)l * 2048 * DM; j.ldw = DM; j.k0 = 64 * (r / 128); j.ns = 32 * (r % 128); j.WT = C.Wup_t() + (size_t)l * DM * YK + 2048; j.ldk = YK; j.nd = j.ns; return j; } r -= IT_UA;
    if (r < IT_UX) { j.W = C.w_up_x + (size_t)l * 512 * DM; j.ldw = DM; j.k0 = 64 * (r / 128); j.ns = 32 * (r % 128); j.WT = C.Wup_t() + (size_t)l * DM * YK + 4096; j.ldk = YK; j.nd = j.ns; return j; } r -= IT_UX;
    if (r < IT_O) { j.W = C.w_out + (size_t)l * DM * DM; j.ldw = DM; j.k0 = 64 * (r / 128); j.ns = 32 * (r % 128); j.WT = C.Wo_t() + (size_t)l * DM * DM; j.ldk = DM; j.nd = j.ns; return j; } r -= IT_O;
    if (r < 2 * IT_W1) { const int c = r / IT_W1; r -= c * IT_W1; j.W = C.cmp_w1 + (size_t)(l * 2 + c) * 4096 * 128; j.ldw = 128; j.k0 = 64 * (r >> 2); j.ns = 32 * (r & 3); j.WT = C.W1_t() + (size_t)(l * 2 + c) * 128 * 4096; j.ldk = 4096; j.nd = j.ns; return j; } r -= 2 * IT_W1;
    { const int c = r / IT_W2; r -= c * IT_W2; j.W = C.cmp_w2 + (size_t)(l * 2 + c) * 128 * 128; j.ldw = 128; j.k0 = 64 * (r >> 2); j.ns = 32 * (r & 3); j.WT = C.W2_t() + (size_t)(l * 2 + c) * 128 * 128; j.ldk = 128; j.nd = j.ns; return j; }
}
__device__ __forceinline__ void p0_prologue(const Ctx& C, LAS unsigned char* lds) {
    const int tid = tid_now(), lane = tid & 63, wave = __builtin_amdgcn_readfirstlane(tid >> 6);
    LAS float* scr = (LAS float*)(lds + wave * 16384);
    const int gw = blockIdx.x * NWAVES + wave, NGW = C.G * NWAVES;
    for (int it = gw; it < NLAY * IT_MKV; it += NGW) { const int l = it / IT_MKV, r = it - l * IT_MKV;
        TrJob j; j.W = C.w_mem_kv + (size_t)l * DM * 1024; j.gs = C.mem_norm_g + l * DM; j.WT = C.Wmkv_t(); j.ldw = 1024; j.k0 = 64 * (r >> 5); j.ns = 32 * (r & 31); j.nvalid = 32; j.ldk = DM; j.nd = l * 1024 + j.ns;
        TrRegs R; tr_load(R, j, lane); tr_store(R, j, scr, lane); }
    for (int row = gw; row < TOK; row += NGW) {
        const f32x4* xr = (const f32x4*)(C.x + (size_t)row * DM) + lane; u32x2* ob = (u32x2*)(C.xb() + (size_t)row * DM) + lane; float ss = 0.f;
#pragma unroll
        for (int j = 0; j < 16; ++j) { const f32x4 v = xr[64 * j]; ss += (v[0] * v[0] + v[1] * v[1]) + (v[2] * v[2] + v[3] * v[3]); u32x2 o; o.x = cvt_pk_bf16(v[0], v[1]); o.y = cvt_pk_bf16(v[2], v[3]); ob[64 * j] = o; }
        C.ssqp()[(size_t)row * 64 + lane] = ss;
    }
    for (int row = gw; row < NBAT * 256; row += NGW) {
        const f32x4* xr = (const f32x4*)(C.mem + (size_t)row * DM) + lane; u32x2* ob = (u32x2*)(C.memb() + (size_t)row * DM) + lane; float ss = 0.f;
#pragma unroll
        for (int j = 0; j < 16; ++j) { const f32x4 v = xr[64 * j]; ss += (v[0] * v[0] + v[1] * v[1]) + (v[2] * v[2] + v[3] * v[3]); u32x2 o; o.x = cvt_pk_bf16(v[0], v[1]); o.y = cvt_pk_bf16(v[2], v[3]); ob[64 * j] = o; }
        ss = wave_sum(ss);
        if (lane == 0) C.rstdm()[row] = 1.0f / sqrtf(ss * (1.0f / DM) + EPS);
    }
}
__device__ __forceinline__ void p0_tables(const Ctx& C) {
    const int tid = tid_now(), lane = tid & 63, wave = __builtin_amdgcn_readfirstlane(tid >> 6);
    const int gw = blockIdx.x * NWAVES + wave, NGW = C.G * NWAVES;
    for (int e = blockIdx.x * 512 + tid; e < SEQ * 64; e += C.G * 512) {
        const int s = e >> 6, i = e & 63;
        double f = 1.0; const double rr = 0.86596432336006535;
        for (int k = 0; k < i; ++k) f *= rr;
        const double a = (double)s * f; const double TWO_PI = 6.283185307179586476925;
        const double kq = __builtin_rint(a / TWO_PI); const double t = a - kq * TWO_PI, t2 = t * t;
        double cs = 1.0, sn = t, term_c = 1.0, term_s = t;
#pragma unroll 1
        for (int k = 1; k <= 13; ++k) { term_c *= -t2 / (double)((2 * k - 1) * (2 * k)); term_s *= -t2 / (double)((2 * k) * (2 * k + 1)); cs += term_c; sn += term_s; }
        C.cost()[e] = (float)cs; C.sint()[e] = (float)sn;
    }
    for (int o = gw; o < NLAY * 2 * 128; o += NGW) {
        const int lc = o >> 7, j = o & 127; const float* pp = C.cmp_pos + (size_t)lc * 4096; const float* ww = C.cmp_w1 + (size_t)lc * 4096 * 128 + j; float s = 0.f;
        { float s1 = 0.f, s2 = 0.f, s3 = 0.f;
#pragma unroll 4
          for (int f = lane; f < 4096; f += 256) { s += pp[f] * ww[(size_t)f * 128]; s1 += pp[f + 64] * ww[(size_t)(f + 64) * 128]; s2 += pp[f + 128] * ww[(size_t)(f + 128) * 128]; s3 += pp[f + 192] * ww[(size_t)(f + 192) * 128]; }
          s = (s + s1) + (s2 + s3); }
        s = wave_sum(s);
        if (lane == 0) C.pb()[o] = s;
    }
}
__device__ __forceinline__ void p0_convert(const Ctx& C, LAS unsigned char* lds, unsigned* qctr) {
    const int tid = tid_now(), lane = tid & 63, wave = __builtin_amdgcn_readfirstlane(tid >> 6);
    LAS float* scr = (LAS float*)(lds + wave * 16384);
    int qcur = 0, qend = 0;
#define TR_NEXT(dst) do { if (qcur == qend) { int b_ = 0; if (lane == 0) b_ = (int)atomicAdd(qctr, (unsigned)TRCH); b_ = __builtin_amdgcn_readfirstlane(b_); qcur = b_; qend = (b_ + TRCH < TR_ITEMS) ? b_ + TRCH : TR_ITEMS; } \
        if (qcur < qend) { dst = qcur; ++qcur; } else { dst = -1; qend = qcur; } } while (0)
    int it; TR_NEXT(it);
    if (it >= 0) {
        TrJob cur = tr_decode(C, it); TrRegs A; tr_load(A, cur, lane);
        for (;;) {
            int nx; TR_NEXT(nx); TrJob nj = cur; TrRegs B = A;
            if (nx >= 0) { nj = tr_decode(C, nx); tr_load(B, nj, lane); }
            tr_store(A, cur, scr, lane);
            if (nx < 0) break;
            cur = nj; A = B;
        }
    }
#undef TR_NEXT
}

__device__ __forceinline__ void rstd_phase(const Ctx& C) {
    const int tid = tid_now(), lane = tid & 63, wave = tid >> 6; const int gw = blockIdx.x * NWAVES + wave, NGW = C.G * NWAVES;
    for (int row0 = gw; row0 < TOK; row0 += 4 * NGW) { float v[4];
#pragma unroll
        for (int k = 0; k < 4; ++k) { const int row = row0 + k * NGW; v[k] = row < TOK ? C.ssqp()[(size_t)row * 64 + lane] : 0.f; }
#pragma unroll
        for (int k = 0; k < 4; ++k) { const int row = row0 + k * NGW; const float s = wave_sum(v[k]); if (lane == 0 && row < TOK) C.rstd()[row] = 1.0f / sqrtf(s * (1.0f / DM) + EPS); } }
}
__device__ __forceinline__ void final_phase(const Ctx& C) {
    const int tid = tid_now(), lane = tid & 63, wave = tid >> 6; const int gw = blockIdx.x * NWAVES + wave, NGW = C.G * NWAVES;
    for (int row = gw; row < TOK; row += NGW) {
        const float s = wave_sum(C.ssqp()[(size_t)row * 64 + lane]); const float rs = 1.0f / sqrtf(s * (1.0f / DM) + EPS);
        const u32x2* xr = (const u32x2*)(C.xb() + (size_t)row * DM) + lane; f32x4* orow = (f32x4*)(C.out + (size_t)row * DM) + lane; const f32x4* gr = (const f32x4*)C.final_g + lane;
#pragma unroll
        for (int j = 0; j < 16; ++j) { const u32x2 xv = xr[64 * j]; const f32x4 v = {bflo(xv.x), bfhi(xv.x), bflo(xv.y), bfhi(xv.y)}; orow[64 * j] = v * rs * gr[64 * j]; }
    }
}

constexpr float SL2 = 0.08838834764831845f * 1.4426950408889634f;
#define MFMA32(a, b, c) __builtin_amdgcn_mfma_f32_32x32x16_bf16((a), (b), (c), 0, 0, 0)
#define MFMA16(a, b, c) __builtin_amdgcn_mfma_f32_16x16x32_bf16((a), (b), (c), 0, 0, 0)
__device__ __forceinline__ void dma_k(LAS unsigned char* kb, const bf16* Kp, int kpitch, int tid, int w) {
#pragma unroll
    for (int q = 0; q < 2; ++q) { const int p = q * 512 + tid, row = p >> 4, c = (p & 15) ^ (row & 15);
        __builtin_amdgcn_global_load_lds((const unsigned*)(Kp + (size_t)row * kpitch + c * 8), (LAS unsigned*)(kb + (q * 512 + w * 64) * 16), 16, 0, 0); }
}
__device__ __forceinline__ void dma_v(LAS unsigned char* vb, const bf16* Vtp, int vts, int tid, int w) {
#pragma unroll
    for (int q = 0; q < 2; ++q) { const int p = q * 512 + tid, d = p >> 3, c = (p & 7) ^ ((d >> 1) & 7);
        __builtin_amdgcn_global_load_lds((const unsigned*)(Vtp + (size_t)d * vts + c * 8), (LAS unsigned*)(vb + (q * 512 + w * 64) * 16), 16, 0, 0); }
}
template <int s> __device__ __forceinline__ bf16x8 pack_step(const f32x16& x) {
    u32x4 p; p.x = cvt_pk_bf16(x[8 * s], x[8 * s + 1]); p.y = cvt_pk_bf16(x[8 * s + 2], x[8 * s + 3]); p.z = cvt_pk_bf16(x[8 * s + 4], x[8 * s + 5]); p.w = cvt_pk_bf16(x[8 * s + 6], x[8 * s + 7]);
    return __builtin_bit_cast(bf16x8, p);
}
__device__ __forceinline__ void qk_tile(f32x16& S0, f32x16& S1, const bf16x8 (&qf)[8], LAS const unsigned char* kb, int lane) {
    const int row = lane & 31, hi = lane >> 5, x = row & 15;
    LAS const unsigned char* kp = kb + row * 256;
#pragma unroll
    for (int r = 0; r < 16; ++r) { S0[r] = 0.f; S1[r] = 0.f; }
#pragma unroll
    for (int st = 0; st < 8; ++st) { const int off = ((2 * st + hi) ^ x) * 16; const bf16x8 k0 = *(LAS const bf16x8*)(kp + off); const bf16x8 k1 = *(LAS const bf16x8*)(kp + 32 * 256 + off);
        S0 = MFMA32(k0, qf[st], S0); S1 = MFMA32(k1, qf[st], S1); }
}
template <int MODE> __device__ __forceinline__ void mask_raw(f32x16& S0, f32x16& S1, int kbase, int tq, int hi) {
    const float NINF = -__builtin_inff();
#pragma unroll
    for (int r = 0; r < 16; ++r) { const int k0 = kbase + (r & 3) + 8 * (r >> 2) + 4 * hi, k1 = k0 + 32;
        if (MODE == 1) { if (16 * k0 + 31 > tq) S0[r] = NINF; if (16 * k1 + 31 > tq) S1[r] = NINF; }
        if (MODE == 2) { if (k0 > tq) S0[r] = NINF; if (k1 > tq) S1[r] = NINF; }
        if (MODE == 3) { if ((unsigned)(tq - k0) >= 512u) S0[r] = NINF; if ((unsigned)(tq - k1) >= 512u) S1[r] = NINF; } }
}
constexpr float DEFER_THR = 8.0f;
template <int MODE> __device__ __forceinline__ void attn_tile(f32x16 (&O)[4], float& m, float& l, const bf16x8 (&qf)[8], LAS const unsigned char* kb, LAS const unsigned char* vb,
                                                                           int lane, int kbase, int tq, bool selbit, bool masked) {
    const float NINF = -__builtin_inff();
    f32x16 S0, S1;
    qk_tile(S0, S1, qf, kb, lane);
    if (MODE != 0 && masked) mask_raw<MODE>(S0, S1, kbase, tq, lane >> 5);
    float mt = NINF;
#pragma unroll
    for (int r = 0; r < 16; ++r) mt = fmaxf(mt, fmaxf(S0[r], S1[r]));
    mt = fmaxf(mt, __shfl_xor(mt, 32)) * SL2;
    if (MODE == 2) mt = selbit ? mt : NINF;
    const bool need = mt > m + DEFER_THR;
    if (__builtin_amdgcn_ballot_w64(need) != 0ull) {
        const float mn = need ? mt : m; const float alpha = __builtin_amdgcn_exp2f(m - mn); m = mn; l *= alpha;
#pragma unroll
        for (int db = 0; db < 4; ++db) O[db] = O[db] * alpha;
    }
    float nb = -m; if (MODE == 2) nb = selbit ? nb : NINF;
    float ls = 0.f;
#pragma unroll
    for (int r = 0; r < 16; ++r) { S0[r] = __builtin_amdgcn_exp2f(__builtin_fmaf(S0[r], SL2, nb)); S1[r] = __builtin_amdgcn_exp2f(__builtin_fmaf(S1[r], SL2, nb)); ls += S0[r] + S1[r]; }
    l += ls;
    const int vrow = lane & 31, vhi = lane >> 5, vx = (vrow >> 1) & 7;
    LAS const unsigned char* vp = vb + vrow * 128;
#define PV_STEP(st4, pfexpr) { const bf16x8 pf = pfexpr; const int voff = ((2 * (st4) + vhi) ^ vx) * 16; _Pragma("unroll") for (int db = 0; db < 4; ++db) { const bf16x8 vf = *(LAS const bf16x8*)(vp + db * 32 * 128 + voff); O[db] = MFMA32(vf, pf, O[db]); } }
    PV_STEP(0, pack_step<0>(S0)) PV_STEP(1, pack_step<1>(S0)) PV_STEP(2, pack_step<0>(S1)) PV_STEP(3, pack_step<1>(S1))
#undef PV_STEP
}
template <int MODE> __device__ __forceinline__ void attn_branch(f32x16 (&O)[4], float& m, float& l, const bf16x8 (&qf)[8], LAS unsigned char* lds, const bf16* Kb, int kpitch, const bf16* Vtb, int vts,
                                                                int jlo, int jhi, int tq, unsigned selmask, int tid, int lane, int w) {
    dma_k(lds + A_KB0, Kb + (size_t)jlo * 64 * kpitch, kpitch, tid, w); dma_v(lds + A_VB0, Vtb + jlo * 64, vts, tid, w);
    asm volatile("s_waitcnt vmcnt(0)" ::: "memory");
    __syncthreads();
    int buf = 0;
    for (int j = jlo; j <= jhi; ++j) {
        if (j < jhi) { dma_k(lds + (buf ? A_KB0 : A_KB1), Kb + (size_t)(j + 1) * 64 * kpitch, kpitch, tid, w); dma_v(lds + (buf ? A_VB0 : A_VB1), Vtb + (j + 1) * 64, vts, tid, w); }
        const bool masked = (MODE == 1) || (MODE == 2 && j == jhi) || (MODE == 3 && (j == jlo || j == jhi));
        attn_tile<MODE>(O, m, l, qf, lds + (buf ? A_KB1 : A_KB0), lds + (buf ? A_VB1 : A_VB0), lane, j * 64, tq, ((selmask >> j) & 1u) != 0u, masked);
        asm volatile("s_waitcnt vmcnt(0)" ::: "memory");
        __syncthreads();
        buf ^= 1;
    }
}
__device__ __forceinline__ void load_q(bf16x8 (&qf)[8], const bf16* qp  ) {
#pragma unroll
    for (int st = 0; st < 8; ++st) qf[st] = *(const bf16x8*)(qp + st * 16);
}
__device__ __forceinline__ float branch_inv(float l) { const float lt = l + __shfl_xor(l, 32); return lt > 0.f ? 1.0f / lt : 0.f; }

__device__ __forceinline__ void nsa_unit(const Ctx& C, int b, int g, int qb, LAS unsigned char* lds) {
    const int tid = tid_now(), lane = tid & 63, w = __builtin_amdgcn_readfirstlane(tid >> 6), hh = w >> 1, th = w & 1, c = lane & 31, hi = lane >> 5;
    const int tq = 64 * qb + 32 * th + c, head = g * 4 + hh; const size_t row = (size_t)b * SEQ + tq;
    const bf16* prow = C.P() + row * NP;
    bf16x8 qf[8];
    load_q(qf, prow + C_NQ + head * 128 + hi * 8);
    const float* ngp = C.ng() + row * 48 + head * 3; const float g0 = ngp[0], g1 = ngp[1], g2 = ngp[2];
    const size_t bg = (size_t)(b * 4 + g);
    f32x16 O[4]; float m, l;
    unsigned* tsc = C.tsc() + ((size_t)(blockIdx.x * NWAVES + w) * 32) * 64 + lane;
#pragma unroll
    for (int db = 0; db < 4; ++db)
#pragma unroll
        for (int r = 0; r < 16; ++r) O[db][r] = 0.f;
    m = -1e30f; l = 0.f;
    const bf16* Kc = C.Kc() + bg * 128 * 128; const bf16* Vtc = C.Vtc() + bg * 128 * 128;
    attn_branch<1>(O, m, l, qf, lds, Kc, 128, Vtc, 128, 0, (qb >= 16) ? 1 : 0, tq, 0u, tid, lane, w);
    const float inv0 = branch_inv(l);
    { const float sc = g0 * inv0;
#pragma unroll
      for (int db = 0; db < 4; ++db)
#pragma unroll
          for (int r = 0; r < 8; ++r) tsc[(db * 8 + r) * 64] = cvt_pk_bf16(O[db][2 * r] * sc, O[db][2 * r + 1] * sc); }
    unsigned selmask = 0xffffffffu;
    if (qb >= 16) {
        dma_k(lds + A_KB0, Kc, 128, tid, w); dma_k(lds + A_KB1, Kc + 64 * 128, 128, tid, w);
        asm volatile("s_waitcnt vmcnt(0)" ::: "memory");
        __syncthreads();
        float Gv[16], Ev[16];
#pragma unroll
        for (int t = 0; t < 2; ++t) {
            f32x16 S0, S1;
            qk_tile(S0, S1, qf, lds + (t ? A_KB1 : A_KB0), lane);
            mask_raw<1>(S0, S1, 64 * t, tq, hi);
#pragma unroll
            for (int r = 0; r < 16; ++r) { S0[r] = __builtin_amdgcn_exp2f(__builtin_fmaf(S0[r], SL2, -m)) * inv0; S1[r] = __builtin_amdgcn_exp2f(__builtin_fmaf(S1[r], SL2, -m)) * inv0; }
#pragma unroll
            for (int q4 = 0; q4 < 4; ++q4) {
                Gv[8 * t + q4] = (S0[4 * q4] + S0[4 * q4 + 1]) + (S0[4 * q4 + 2] + S0[4 * q4 + 3]); Ev[8 * t + q4] = S0[4 * q4 + 3];
                Gv[8 * t + 4 + q4] = (S1[4 * q4] + S1[4 * q4 + 1]) + (S1[4 * q4 + 2] + S1[4 * q4 + 3]); Ev[8 * t + 4 + q4] = S1[4 * q4 + 3]; }
        }
        float rv[16];
#pragma unroll
        for (int i = 0; i < 16; ++i) rv[i] = __shfl_xor(Ev[i], 32);
        LAS float* impw = (LAS float*)(lds + A_IMPW) + (w * 32 + c) * 33;
#pragma unroll
        for (int i = 0; i < 16; ++i) { const float add = hi ? rv[i] : (i > 0 ? rv[i > 0 ? i - 1 : 0] : 0.f); impw[2 * i + hi] = Gv[i] + add; }
        __syncthreads();
        {
            const int tk = tid >> 3, part = tid & 7, tth = tk >> 5, cc = tk & 31; LAS const float* iw = (LAS const float*)(lds + A_IMPW); LAS float* is = (LAS float*)(lds + A_IMPS);
#pragma unroll
            for (int jj = 0; jj < 4; ++jj) { const int j = 4 * part + jj; float s = 0.f;
#pragma unroll
                for (int h4 = 0; h4 < 4; ++h4) s += iw[((2 * h4 + tth) * 32 + cc) * 33 + j];
                is[tk * 33 + j] = s; }
        }
        __syncthreads();
        {
            const int tk = tid >> 3, part = tid & 7; LAS const float* is = (LAS const float*)(lds + A_IMPS) + tk * 33; const float PINF = __builtin_inff();
            unsigned bits = 0u;
#pragma unroll
            for (int jj = 0; jj < 4; ++jj) { const int j = 4 * part + jj;
                const float vj = (j > qb) ? -PINF : ((j == 0 || j == qb || j == qb - 1) ? PINF : is[j]); int cnt = 0;
                for (int k = 0; k < 32; ++k) { const float vk = (k > qb) ? -PINF : ((k == 0 || k == qb || k == qb - 1) ? PINF : is[k]); cnt += (vk > vj || (vk == vj && k < j)) ? 1 : 0; }
                if (cnt < 16) bits |= 1u << j; }
            bits |= __shfl_xor(bits, 1); bits |= __shfl_xor(bits, 2); bits |= __shfl_xor(bits, 4);
            if (part == 0) ((LAS unsigned*)(lds + A_SELM))[tk] = bits;
        }
        __syncthreads();
        selmask = ((LAS const unsigned*)(lds + A_SELM))[32 * th + c];
    }
    { const float* cs = C.cost() + (size_t)tq * 64 + hi * 8; const float* sn = C.sint() + (size_t)tq * 64 + hi * 8;
#pragma unroll
      for (int st = 0; st < 4; ++st) {
          const f32x4 c0 = *(const f32x4*)(cs + st * 16), c1 = *(const f32x4*)(cs + st * 16 + 4), s0 = *(const f32x4*)(sn + st * 16), s1 = *(const f32x4*)(sn + st * 16 + 4);
          const u32x4 a = __builtin_bit_cast(u32x4, qf[st]), bq = __builtin_bit_cast(u32x4, qf[st + 4]); u32x4 oa, ob;
#pragma unroll
          for (int e2 = 0; e2 < 4; ++e2) { const float x1l = bflo(a[e2]), x1h = bfhi(a[e2]), x2l = bflo(bq[e2]), x2h = bfhi(bq[e2]);
              const float cl = (e2 < 2) ? c0[2 * e2] : c1[2 * e2 - 4], ch = (e2 < 2) ? c0[2 * e2 + 1] : c1[2 * e2 - 3], sl = (e2 < 2) ? s0[2 * e2] : s1[2 * e2 - 4], sh = (e2 < 2) ? s0[2 * e2 + 1] : s1[2 * e2 - 3];
              oa[e2] = cvt_pk_bf16(x1l * cl - x2l * sl, x1h * ch - x2h * sh); ob[e2] = cvt_pk_bf16(x2l * cl + x1l * sl, x2h * ch + x1h * sh); }
          qf[st] = __builtin_bit_cast(bf16x8, oa); qf[st + 4] = __builtin_bit_cast(bf16x8, ob); } }
#pragma unroll
    for (int db = 0; db < 4; ++db)
#pragma unroll
        for (int r = 0; r < 16; ++r) O[db][r] = 0.f;
    m = -1e30f; l = 0.f;
    attn_branch<2>(O, m, l, qf, lds, C.Kr() + bg * SEQ * 128, 128, C.Vt() + bg * 128 * SEQ, SEQ, 0, qb, tq, selmask, tid, lane, w);
    { const float sc = g1 * branch_inv(l);
#pragma unroll
      for (int db = 0; db < 4; ++db)
#pragma unroll
          for (int r = 0; r < 8; ++r) { const unsigned t = tsc[(db * 8 + r) * 64]; tsc[(db * 8 + r) * 64] = cvt_pk_bf16(bflo(t) + O[db][2 * r] * sc, bfhi(t) + O[db][2 * r + 1] * sc); } }
#pragma unroll
    for (int db = 0; db < 4; ++db)
#pragma unroll
        for (int r = 0; r < 16; ++r) O[db][r] = 0.f;
    m = -1e30f; l = 0.f;
    attn_branch<3>(O, m, l, qf, lds, C.Kr() + (16 + bg) * SEQ * 128, 128, C.Vt() + (16 + bg) * 128 * SEQ, SEQ, (qb > 8) ? qb - 8 : 0, qb, tq, 0u, tid, lane, w);
    { const float sc = g2 * branch_inv(l);
      const bf16* zp = prow + C_NZ + head * 128 + 4 * hi; bf16* op = C.Y() + row * YK + 2048 + head * 128 + 4 * hi;
#pragma unroll
      for (int db = 0; db < 4; ++db)
#pragma unroll
          for (int q4 = 0; q4 < 4; ++q4) { const u32x2 zz = *(const u32x2*)(zp + 32 * db + 8 * q4); const unsigned t0 = tsc[(db * 8 + 2 * q4) * 64], t1 = tsc[(db * 8 + 2 * q4 + 1) * 64];
              const float o0 = (bflo(t0) + O[db][4 * q4] * sc) * siluf_(bflo(zz.x)), o1 = (bfhi(t0) + O[db][4 * q4 + 1] * sc) * siluf_(bfhi(zz.x));
              const float o2 = (bflo(t1) + O[db][4 * q4 + 2] * sc) * siluf_(bflo(zz.y)), o3 = (bfhi(t1) + O[db][4 * q4 + 3] * sc) * siluf_(bfhi(zz.y));
              u32x2 ov; ov.x = cvt_pk_bf16(o0, o1); ov.y = cvt_pk_bf16(o2, o3); *(u32x2*)(op + 32 * db + 8 * q4) = ov; } }
}

__device__ __forceinline__ void mem_unit(const Ctx& C, int l_, int b, int h, int tb, LAS unsigned char* lds) {
    const int tid = tid_now(), lane = tid & 63, w = __builtin_amdgcn_readfirstlane(tid >> 6), c = lane & 31, hi = lane >> 5;
    const int tq = 256 * tb + 32 * w + c; const size_t row = (size_t)b * SEQ + tq; const bf16* prow = C.P() + row * NP;
    bf16x8 qf[8];
    load_q(qf, prow + C_XQ + h * 128 + hi * 8);
    f32x16 O[4]; float m = -1e30f, l = 0.f;
#pragma unroll
    for (int db = 0; db < 4; ++db)
#pragma unroll
        for (int r = 0; r < 16; ++r) O[db][r] = 0.f;
    const size_t hb = (size_t)((l_ * 4 + b) * 4 + h);
    attn_branch<0>(O, m, l, qf, lds, C.memK() + hb * 256 * 128, 128, C.memVt() + hb * 128 * 256, 256, 0, 3, tq, 0u, tid, lane, w);
    const float sc = branch_inv(l);
    const bf16* zp = prow + C_XZ + h * 128 + 4 * hi; bf16* op = C.Y() + row * YK + 4096 + h * 128 + 4 * hi;
#pragma unroll
    for (int db = 0; db < 4; ++db)
#pragma unroll
        for (int q4 = 0; q4 < 4; ++q4) { const u32x2 zz = *(const u32x2*)(zp + 32 * db + 8 * q4);
            u32x2 ov; ov.x = cvt_pk_bf16(O[db][4 * q4] * sc * siluf_(bflo(zz.x)), O[db][4 * q4 + 1] * sc * siluf_(bfhi(zz.x)));
            ov.y = cvt_pk_bf16(O[db][4 * q4 + 2] * sc * siluf_(bflo(zz.y)), O[db][4 * q4 + 3] * sc * siluf_(bfhi(zz.y))); *(u32x2*)(op + 32 * db + 8 * q4) = ov; }
}

__device__ __forceinline__ void cmp_item(const Ctx& C, int l_, int item, LAS unsigned char* lds) {
    const int tid = tid_now(), lane = tid & 63, w = __builtin_amdgcn_readfirstlane(tid >> 6), r16 = lane & 15, quad = lane >> 4;
    const int nb = item & 7, c = (item >> 3) & 1, g = (item >> 4) & 3, b = item >> 6, n0 = 16 * nb;
    int n = n0 + r16; if (n > 126) n = 126;
    f32x4 acc[8];
#pragma unroll
    for (int cb = 0; cb < 8; ++cb) acc[cb] = (f32x4){0.f, 0.f, 0.f, 0.f};
    const bf16* W1 = C.W1_t() + (size_t)(l_ * 2 + c) * 128 * 4096;
    const bf16* abase = C.P() + ((size_t)b * SEQ + 16 * n) * NP + C_KV + (c * 4 + g) * 128 + quad * 8;
    bf16x8 av[4][4];
#pragma unroll
    for (int ll = 0; ll < 4; ++ll)
#pragma unroll
        for (int ks = 0; ks < 4; ++ks) av[ll][ks] = *(const bf16x8*)(abase + (size_t)(4 * w + ll) * NP + ks * 32);
#pragma unroll
    for (int ll = 0; ll < 4; ++ll) { const int lpos = 4 * w + ll; const bf16* bp = W1 + (size_t)r16 * 4096 + lpos * 128 + quad * 8;
#pragma unroll
        for (int ks = 0; ks < 4; ++ks) { bf16x8 bv[8];
#pragma unroll
            for (int cb = 0; cb < 8; ++cb) bv[cb] = *(const bf16x8*)(bp + (size_t)cb * 16 * 4096 + ks * 32);
#pragma unroll
            for (int cb = 0; cb < 8; ++cb) acc[cb] = MFMA16(av[ll][ks], bv[cb], acc[cb]); } }
    LAS float* red = (LAS float*)lds;
#pragma unroll
    for (int cb = 0; cb < 8; ++cb)
#pragma unroll
        for (int i = 0; i < 4; ++i) red[(w * 16 + 4 * quad + i) * 128 + 16 * cb + r16] = acc[cb][i];
    __syncthreads();
    LAS bf16* hid = (LAS bf16*)(lds + 65536);
#pragma unroll
    for (int q = 0; q < 4; ++q) { const int o = tid + 512 * q, rr = o >> 7, col = o & 127; float s = C.pb()[(l_ * 2 + c) * 128 + col];
#pragma unroll
        for (int ww = 0; ww < 8; ++ww) s += red[(ww * 16 + rr) * 128 + col];
        hid[rr * 136 + col] = f2bf(siluf_(s)); }
    __syncthreads();
    const bf16* W2 = C.W2_t() + (size_t)(l_ * 2 + c) * 128 * 128; f32x4 a2 = (f32x4){0.f, 0.f, 0.f, 0.f};
#pragma unroll
    for (int ks = 0; ks < 4; ++ks) { const bf16x8 a = *(LAS const bf16x8*)(hid + r16 * 136 + ks * 32 + quad * 8); const bf16x8 bb = *(const bf16x8*)(W2 + (size_t)(16 * w + r16) * 128 + ks * 32 + quad * 8); a2 = MFMA16(a, bb, a2); }
    const size_t bg = (size_t)(b * 4 + g); const int col = 16 * w + r16;
#pragma unroll
    for (int i = 0; i < 4; ++i) { const int nn = n0 + 4 * quad + i; const bf16 v = f2bf(nn < 127 ? a2[i] : 0.f);
        if (c == 0) C.Kc()[(bg * 128 + nn) * 128 + col] = v; else C.Vtc()[(bg * 128 + col) * 128 + ((nn & ~15) | perm16(nn & 15))] = v; }
    __syncthreads();
}
__device__ __forceinline__ void ropevt_item(const Ctx& C, int item, LAS unsigned char* lds) {
    const int tid = tid_now(); const int j0 = (item & 7) * 4, g = (item >> 3) & 3, b = (item >> 5) & 3, brk = item >> 7, br = brk + 1;
    const size_t bg = (size_t)(brk * 16 + b * 4 + g);
    {
        const int s = tid >> 3, d0 = 8 * (tid & 7); u32x4 a[4], bq[4]; f32x4 c0[4], c1[4], s0[4], s1[4];
#pragma unroll
        for (int u = 0; u < 4; ++u) { const int tok = 64 * (j0 + u) + s; const bf16* src = C.P() + ((size_t)b * SEQ + tok) * NP + C_KV + ((br * 2 + 0) * 4 + g) * 128 + d0;
            a[u] = *(const u32x4*)src; bq[u] = *(const u32x4*)(src + 64);
            const float* cs = C.cost() + (size_t)tok * 64 + d0; const float* sn = C.sint() + (size_t)tok * 64 + d0;
            c0[u] = *(const f32x4*)cs; c1[u] = *(const f32x4*)(cs + 4); s0[u] = *(const f32x4*)sn; s1[u] = *(const f32x4*)(sn + 4); }
#pragma unroll
        for (int u = 0; u < 4; ++u) { const int tok = 64 * (j0 + u) + s; u32x4 oa, ob;
#pragma unroll
            for (int e2 = 0; e2 < 4; ++e2) { const float x1l = bflo(a[u][e2]), x1h = bfhi(a[u][e2]), x2l = bflo(bq[u][e2]), x2h = bfhi(bq[u][e2]);
                const float cl = (e2 < 2) ? c0[u][2 * e2] : c1[u][2 * e2 - 4], ch = (e2 < 2) ? c0[u][2 * e2 + 1] : c1[u][2 * e2 - 3], sl = (e2 < 2) ? s0[u][2 * e2] : s1[u][2 * e2 - 4], sh = (e2 < 2) ? s0[u][2 * e2 + 1] : s1[u][2 * e2 - 3];
                oa[e2] = cvt_pk_bf16(x1l * cl - x2l * sl, x1h * ch - x2h * sh); ob[e2] = cvt_pk_bf16(x2l * cl + x1l * sl, x2h * ch + x1h * sh); }
            bf16* dst = C.Kr() + (bg * SEQ + tok) * 128 + d0; *(u32x4*)dst = oa; *(u32x4*)(dst + 64) = ob; }
    }
    {
        LAS bf16* vt = (LAS bf16*)lds; u32x4 v[8];
#pragma unroll
        for (int q = 0; q < 8; ++q) { const int id = tid + 512 * (q & 1), s = id >> 4, ch = id & 15, u = q >> 1;
            v[q] = *(const u32x4*)(C.P() + ((size_t)b * SEQ + 64 * (j0 + u) + s) * NP + C_KV + ((br * 2 + 1) * 4 + g) * 128 + ch * 8); }
#pragma unroll
        for (int q = 0; q < 8; ++q) { const int id = tid + 512 * (q & 1), s = id >> 4, ch = id & 15, u = q >> 1;
            LAS unsigned* d = (LAS unsigned*)(vt + u * (64 * 130) + s * 130 + ch * 8); d[0] = v[q].x; d[1] = v[q].y; d[2] = v[q].z; d[3] = v[q].w; }
        __syncthreads();
#pragma unroll
        for (int q = 0; q < 8; ++q) { const int id = tid + 512 * (q & 1), d = id >> 3, pc = id & 7, u = q >> 1; unsigned short e[8];
#pragma unroll
            for (int k = 0; k < 8; ++k) { const int key = 16 * (pc >> 1) + 8 * (k >> 2) + 4 * (pc & 1) + (k & 3); e[k] = vt[u * (64 * 130) + key * 130 + d]; }
            u32x4 o; o.x = e[0] | ((unsigned)e[1] << 16); o.y = e[2] | ((unsigned)e[3] << 16); o.z = e[4] | ((unsigned)e[5] << 16); o.w = e[6] | ((unsigned)e[7] << 16);
            *(u32x4*)(C.Vt() + (bg * 128 + d) * SEQ + 64 * (j0 + u) + 8 * pc) = o; }
        __syncthreads();
    }
}
__device__ __forceinline__ void gate_item(const Ctx& C, int l_, int item, LAS unsigned char* lds) {
    const int tid = tid_now(), lane = tid & 63, w = __builtin_amdgcn_readfirstlane(tid >> 6), r16 = lane & 15, quad = lane >> 4;
    const bf16* ap = C.xb() + (size_t)(32 * item + r16) * DM + w * 512 + quad * 8;
    const bf16* bp = C.Wg_t() + (size_t)l_ * 64 * DM + (size_t)r16 * DM + w * 512 + quad * 8;
    f32x4 acc[2][3];
#pragma unroll
    for (int rb = 0; rb < 2; ++rb)
#pragma unroll
        for (int cb = 0; cb < 3; ++cb) acc[rb][cb] = (f32x4){0.f, 0.f, 0.f, 0.f};
#pragma unroll
    for (int k0 = 0; k0 < 16; k0 += 8) { bf16x8 ag[2][8];
#pragma unroll
        for (int ks = 0; ks < 8; ++ks) { ag[0][ks] = *(const bf16x8*)(ap + (k0 + ks) * 32); ag[1][ks] = *(const bf16x8*)(ap + (size_t)16 * DM + (k0 + ks) * 32); }
#pragma unroll
        for (int ks = 0; ks < 8; ++ks) {
#pragma unroll
            for (int cb = 0; cb < 3; ++cb) { const bf16x8 bb = *(const bf16x8*)(bp + (size_t)cb * 16 * DM + (k0 + ks) * 32); acc[0][cb] = MFMA16(ag[0][ks], bb, acc[0][cb]); acc[1][cb] = MFMA16(ag[1][ks], bb, acc[1][cb]); } } }
    LAS float* red = (LAS float*)lds;
#pragma unroll
    for (int rb = 0; rb < 2; ++rb)
#pragma unroll
        for (int cb = 0; cb < 3; ++cb)
#pragma unroll
            for (int i = 0; i < 4; ++i) red[(w * 32 + 16 * rb + 4 * quad + i) * 48 + 16 * cb + r16] = acc[rb][cb][i];
    __syncthreads();
    for (int o = tid; o < 32 * 48; o += 512) { const int rr = o / 48, col = o - rr * 48; float s = 0.f;
#pragma unroll
        for (int q = 0; q < 8; ++q) s += red[(q * 32 + rr) * 48 + col];
        const int row = 32 * item + rr; C.ng()[(size_t)row * 48 + col] = sigmoidf_(s * C.rstd()[row]); }
    __syncthreads();
}
__device__ __forceinline__ void memvt_item(const Ctx& C, int item, LAS unsigned char* lds) {
    const int tid = tid_now(); const int t = item & 3, h = (item >> 2) & 3, b = (item >> 4) & 3, l_ = item >> 6;
    LAS bf16* vt = (LAS bf16*)lds;
#pragma unroll
    for (int q = 0; q < 2; ++q) { const int id = tid + 512 * q, s = id >> 4, ch = id & 15;
        *(u32x4*)(C.memK() + ((size_t)((l_ * 4 + b) * 4 + h) * 256 + 64 * t + s) * 128 + ch * 8) = *(const u32x4*)(C.MKV() + ((size_t)b * 256 + 64 * t + s) * 4096 + l_ * 1024 + h * 128 + ch * 8);
        const u32x4 v = *(const u32x4*)(C.MKV() + ((size_t)b * 256 + 64 * t + s) * 4096 + l_ * 1024 + 512 + h * 128 + ch * 8);
        LAS unsigned* d = (LAS unsigned*)(vt + s * 130 + ch * 8); d[0] = v.x; d[1] = v.y; d[2] = v.z; d[3] = v.w; }
    __syncthreads();
    const size_t hb = (size_t)((l_ * 4 + b) * 4 + h);
#pragma unroll
    for (int q = 0; q < 2; ++q) { const int id = tid + 512 * q, d = id >> 3, pc = id & 7; unsigned short e[8];
#pragma unroll
        for (int k = 0; k < 8; ++k) { const int key = 16 * (pc >> 1) + 8 * (k >> 2) + 4 * (pc & 1) + (k & 3); e[k] = vt[key * 130 + d]; }
        u32x4 o; o.x = e[0] | ((unsigned)e[1] << 16); o.y = e[2] | ((unsigned)e[3] << 16); o.z = e[4] | ((unsigned)e[5] << 16); o.w = e[6] | ((unsigned)e[7] << 16);
        *(u32x4*)(C.memVt() + (hb * 128 + d) * 256 + 64 * t + 8 * pc) = o; }
    __syncthreads();
}
__device__ __forceinline__ void conv_item(const Ctx& C, int l_, int item) {
    const int tid = tid_now(); const int ch = (tid & 255) * 8, t0 = 64 * item + 32 * (tid >> 8), sp0 = t0 & (SEQ - 1);
    const float* cw = C.conv_w + (size_t)l_ * 3 * 2048 + ch; const float* cbv = C.conv_b + (size_t)l_ * 2048 + ch;
    float w[3][8], bias[8], u1[8], u2[8];
#pragma unroll
    for (int k = 0; k < 3; ++k) { const f32x4 a = *(const f32x4*)(cw + k * 2048), c = *(const f32x4*)(cw + k * 2048 + 4); w[k][0] = a[0]; w[k][1] = a[1]; w[k][2] = a[2]; w[k][3] = a[3]; w[k][4] = c[0]; w[k][5] = c[1]; w[k][6] = c[2]; w[k][7] = c[3]; }
    { const f32x4 a = *(const f32x4*)cbv, c = *(const f32x4*)(cbv + 4); bias[0] = a[0]; bias[1] = a[1]; bias[2] = a[2]; bias[3] = a[3]; bias[4] = c[0]; bias[5] = c[1]; bias[6] = c[2]; bias[7] = c[3]; }
    const bf16* p = C.P() + (size_t)t0 * NP + ch;
#pragma unroll
    for (int e = 0; e < 8; ++e) { u1[e] = 0.f; u2[e] = 0.f; }
    if (sp0 >= 1) { const u32x4 hv = *(const u32x4*)(p - NP + C_AH), cv = *(const u32x4*)(p - NP + C_AC);
#pragma unroll
        for (int e2 = 0; e2 < 4; ++e2) { u1[2 * e2] = bflo(hv[e2]) * bflo(cv[e2]); u1[2 * e2 + 1] = bfhi(hv[e2]) * bfhi(cv[e2]); } }
    if (sp0 >= 2) { const u32x4 hv = *(const u32x4*)(p - 2 * (size_t)NP + C_AH), cv = *(const u32x4*)(p - 2 * (size_t)NP + C_AC);
#pragma unroll
        for (int e2 = 0; e2 < 4; ++e2) { u2[2 * e2] = bflo(hv[e2]) * bflo(cv[e2]); u2[2 * e2 + 1] = bfhi(hv[e2]) * bfhi(cv[e2]); } }
    bf16* yo = C.Y() + (size_t)t0 * YK + ch;
#pragma unroll 8
    for (int s = 0; s < 32; ++s) { const bf16* ps = p + (size_t)s * NP;
        const u32x4 hv = *(const u32x4*)(ps + C_AH), cv = *(const u32x4*)(ps + C_AC), bv = *(const u32x4*)(ps + C_AB), zv = *(const u32x4*)(ps + C_AZ); u32x4 o;
#pragma unroll
        for (int e2 = 0; e2 < 4; ++e2) { const float ul = bflo(hv[e2]) * bflo(cv[e2]), uh = bfhi(hv[e2]) * bfhi(cv[e2]);
            float yl = bias[2 * e2], yh = bias[2 * e2 + 1];
            yl += w[0][2 * e2] * u2[2 * e2]; yh += w[0][2 * e2 + 1] * u2[2 * e2 + 1];
            yl += w[1][2 * e2] * u1[2 * e2]; yh += w[1][2 * e2 + 1] * u1[2 * e2 + 1];
            yl += w[2][2 * e2] * ul; yh += w[2][2 * e2 + 1] * uh;
            u2[2 * e2] = u1[2 * e2]; u2[2 * e2 + 1] = u1[2 * e2 + 1]; u1[2 * e2] = ul; u1[2 * e2 + 1] = uh;
            o[e2] = cvt_pk_bf16(bflo(bv[e2]) * yl * siluf_(bflo(zv[e2])), bfhi(bv[e2]) * yh * siluf_(bfhi(zv[e2]))); }
        *(u32x4*)(yo + (size_t)s * YK) = o; }
}


#define GAS __attribute__((address_space(1)))
typedef float f32x4g __attribute__((ext_vector_type(4)));
__device__ __noinline__ void rstd_table(const GAS float* sp0, GAS float* rg, LAS float* rt) {
    const int t = threadIdx.x, row = t >> 1, half = t & 1; const GAS float* sp = sp0 + (size_t)row * 64 + half * 32; float s = 0.f;
#pragma unroll
    for (int k = 0; k < 8; ++k) { const f32x4 v = *(const GAS f32x4*)(sp + 4 * k); s += (v[0] + v[1]) + (v[2] + v[3]); }
    const float so = __shfl_xor(s, 1); const float tot = half ? (so + s) : (s + so); const float rs = 1.0f / sqrtf(tot * (1.0f / 4096.0f) + 1e-6f);
    if (half == 0) { rt[row] = rs; rg[row] = rs; }
}
constexpr int N_PHASES = 2 + 5 * NLAY + 1;
struct Args { const float* in[16]; float* out; unsigned char* ws; int ph_lo, ph_hi, li, pad; };
__global__ void __launch_bounds__(NWAVES * 64, 2) fwd(Args args) {
    extern __shared__ __attribute__((aligned(16))) unsigned char lds_raw[];
    LAS unsigned char* lds = (LAS unsigned char*)lds_raw;
    volatile LAS unsigned* MISC = (volatile LAS unsigned*)(lds + MISC_OFF);
    const int tid = tid_now();
    Ctx C;
    C.x = args.in[0]; C.mem = args.in[1]; C.norm_g = args.in[2]; C.w_in = args.in[3]; C.conv_w = args.in[4]; C.conv_b = args.in[5]; C.cmp_pos = args.in[6]; C.cmp_w1 = args.in[7];
    C.cmp_w2 = args.in[8]; C.mem_norm_g = args.in[9]; C.w_mem_kv = args.in[10]; C.w_up_a = args.in[11]; C.w_up_b = args.in[12]; C.w_up_x = args.in[13]; C.w_out = args.in[14]; C.final_g = args.in[15];
    C.out = args.out;
    unsigned char* ws = args.ws; C.ws = ws;
    C.G = gridDim.x; { const int bx = blockIdx.x; C.vcu = (C.G % 8 == 0) ? (bx % 8) * (C.G / 8) + bx / 8 : bx; }
    for (int u = tid; u < (LDS_BYTES - RING_BYTES) / 4; u += NWAVES * 64) ((LAS unsigned*)(lds + RING_BYTES))[u] = 0u;
    __syncthreads();
    const int lo = args.ph_lo, hi = args.ph_hi;
    const bool use_bar = (hi - lo) > 1;
    XcdBarrier bar; bar.bar = (unsigned*)(ws) + CW_BAR + args.li * XCD_BAR_WORDS; bar.x = 0; bar.st = MISC + 8;
    if (use_bar) bar = xcd_barrier_post((unsigned*)(ws) + CW_BAR + args.li * XCD_BAR_WORDS, MISC + 8);
#ifndef PHMASK
#define PHMASK 0xff
#endif
#define IN(k) (lo <= (k) && (k) < hi)
#define RELAUNDER() do { size_t z_ = 0; asm volatile("" : "+s"(z_)); C.ws = ws + z_; } while (0)
#define EN(b) ((PHMASK >> (b)) & 1)
#if defined(DOUBLE_BAR)
#define SEAM(k) do { if (IN(k) && IN((k) + 1)) { xcd_barrier(bar); xcd_barrier(bar); } } while (0)
#else
#define SEAM(k) do { if (IN(k) && IN((k) + 1)) xcd_barrier(bar); } while (0)
#endif

    if (EN(0) && IN(0)) { RELAUNDER(); p0_prologue(C, lds); __syncthreads(); }
    SEAM(0);
    if (EN(1) && IN(1)) { RELAUNDER();
        pg8::Gemm g{C.memb(), C.Wmkv_t(), NBAT * 256, 4096, DM}; pg8::StaticOrder S; S.init(NBAT * 256, 4096, C.G, bx_now());
        pg8::EpiProj E{C.MKV(), 4096, C.rstdm(), nullptr, nullptr, 0, 1 << 30};
        pg8::gemm_phase<pg8::EpiProj, pg8::StaticOrder, true, true>(lds, g, S, E);
        p0_tables(C);
        p0_convert(C, lds, (unsigned*)(ws) + CW_Q + 64 * args.li);
    }
    SEAM(1);
    for (int l = 0; l < NLAY; ++l) {
        const int pA = 2 + 5 * l;
        if (EN(2) && IN(pA)) { RELAUNDER();
            if (l == 0) { for (int it = blockIdx.x; it < 256; it += C.G) memvt_item(C, it, lds); }
            pg8::Gemm g{C.xb(), C.Win_t() + (size_t)l * NP * DM, TOK, NP, DM}; pg8::StaticOrder S; S.init(TOK, NP, C.G, bx_now()); S.mix = 1;
            PG8_LAS float* rt = (PG8_LAS float*)(lds + RT_OFF); int pm0 = -1; { pg8::Unit u0; if (S.next(0, u0)) pm0 = u0.pm; }
            if (pm0 >= 0) rstd_table((const GAS float*)(C.ssqp() + (size_t)pm0 * 256 * 64), (GAS float*)(C.rstd() + pm0 * 256), rt);
            __syncthreads();
            pg8::EpiProj E{C.P(), NP, nullptr, rt, C.G8(), 3 * DM, C_MG / 256};
            pg8::gemm_phase<pg8::EpiProj, pg8::StaticOrder, true, true>(lds, g, S, E);
        }
        SEAM(pA);
        if (EN(3) && IN(pA + 1)) { RELAUNDER();
            for (int it = blockIdx.x; it < 128 + 128 + 256 + 256 + 256; it += C.G) {
                if (it < 128) { mem_unit(C, l, it >> 5, (it >> 3) & 3, it & 7, lds); }
                else if (it < 256) { conv_item(C, l, it - 128); }
                else if (it < 512) { cmp_item(C, l, it - 256, lds); }
                else if (it < 768) { ropevt_item(C, it - 512, lds); }
                else { gate_item(C, l, it - 768, lds); }
            }
        }
        SEAM(pA + 1);
        if (EN(4) && IN(pA + 2)) { RELAUNDER();
            for (int it = C.vcu; it < 256; it += C.G) { const int bg = it >> 4, pr = it & 15; nsa_unit(C, bg >> 2, bg & 3, 31 - pr, lds); nsa_unit(C, bg >> 2, bg & 3, pr, lds); }
        }
        SEAM(pA + 2);
        if (EN(5) && IN(pA + 3)) { RELAUNDER();
            pg8::Gemm g{C.Y(), C.Wup_t() + (size_t)l * DM * YK, TOK, DM, YK}; pg8::StaticOrder S; S.init(TOK, DM, C.G, bx_now());
            pg8::EpiUpF E{C.G8(), 3 * DM, DM, C.UB(), DM};
            pg8::gemm_phase<pg8::EpiUpF, pg8::StaticOrder, true, true>(lds, g, S, E);
        }
        SEAM(pA + 3);
        if (EN(6) && IN(pA + 4)) { RELAUNDER();
            pg8::Gemm g{C.UB(), C.Wo_t() + (size_t)l * DM * DM, TOK, DM, DM}; pg8::StaticOrder S; S.init(TOK, DM, C.G, bx_now());
            pg8::EpiOut E{C.xb(), C.ssqp(), DM};
            pg8::gemm_phase<pg8::EpiOut, pg8::StaticOrder, true, true>(lds, g, S, E);
        }
        SEAM(pA + 4);
    }
    if (EN(7) && IN(2 + 5 * NLAY)) { RELAUNDER(); final_phase(C); }
#undef IN
#undef EN
#undef SEAM
}


#ifndef N_LAUNCH_SPLIT
#define N_LAUNCH_SPLIT 0
#endif
extern "C" void kernel_launch(void* const* d_in, const int* in_sizes, int n_in, void* d_out, int out_size, void* d_ws, size_t ws_size, hipStream_t stream) {
    static int grid = 0;
    if (grid == 0) {
        if (n_in != 16 || out_size != TOK * DM || ws_size < WS_END) { fprintf(stderr, "kernel_launch: unexpected shapes (n_in %d, out %d, ws %zu < %zu)\n", n_in, out_size, ws_size, (size_t)WS_END); grid = -1; return; }
        int dev = 0, cus = 0;
        if (hipGetDevice(&dev) != hipSuccess || hipDeviceGetAttribute(&cus, hipDeviceAttributeMultiprocessorCount, dev) != hipSuccess) { grid = -1; return; }
        if (hipFuncSetAttribute((const void*)fwd, hipFuncAttributeMaxDynamicSharedMemorySize, LDS_BYTES) != hipSuccess) { fprintf(stderr, "kernel_launch: hipFuncSetAttribute failed\n"); grid = -1; return; }
        int per_cu = 0;
        if (hipOccupancyMaxActiveBlocksPerMultiprocessor(&per_cu, (const void*)fwd, NWAVES * 64, LDS_BYTES) != hipSuccess || per_cu < 1) fprintf(stderr, "kernel_launch: occupancy query says %d blocks per CU\n", per_cu);
        (void)hipGetLastError();
        grid = cus;
        { pg8::StaticOrder S; bool fixed = true;
          for (int c = 0; c < grid && fixed; ++c) { S.init(TOK, NP, grid, c); pg8::Unit u0, u; if (!S.next(0, u0)) continue; for (int i = 1; S.next(i, u); ++i) if (u.pm != u0.pm) { fixed = false; break; } }
          if (!fixed) { fprintf(stderr, "kernel_launch: unit order does not keep a workgroup inside one row panel at grid %d; nothing launched\n", grid); grid = -1; return; } }
    }
    if (grid < 0) return;
    (void)hipMemsetAsync(d_ws, 0, CTL_BYTES, stream);
    Args a{};
    for (int i = 0; i < 16; ++i) a.in[i] = (const float*)d_in[i];
    a.out = (float*)d_out; a.ws = (unsigned char*)d_ws;
#if N_LAUNCH_SPLIT
    for (int ph = 0; ph < N_PHASES; ++ph) { a.ph_lo = ph; a.ph_hi = ph + 1; hipLaunchKernelGGL(fwd, dim3(grid), dim3(NWAVES * 64), LDS_BYTES, stream, a);
    }
#elif defined(REPEAT_LO)
    a.ph_lo = 0; a.ph_hi = REPEAT_HI; a.li = 0; hipLaunchKernelGGL(fwd, dim3(grid), dim3(NWAVES * 64), LDS_BYTES, stream, a);
    a.ph_lo = REPEAT_LO; a.ph_hi = N_PHASES; a.li = 1; hipLaunchKernelGGL(fwd, dim3(grid), dim3(NWAVES * 64), LDS_BYTES, stream, a);
#elif defined(REPEAT_PH)
    a.ph_lo = 0; a.ph_hi = REPEAT_PH + 1; a.li = 0; hipLaunchKernelGGL(fwd, dim3(grid), dim3(NWAVES * 64), LDS_BYTES, stream, a);
    a.ph_lo = REPEAT_PH; a.ph_hi = N_PHASES; a.li = 1; hipLaunchKernelGGL(fwd, dim3(grid), dim3(NWAVES * 64), LDS_BYTES, stream, a);
#else
    a.ph_lo = 0; a.ph_hi = N_PHASES; hipLaunchKernelGGL(fwd, dim3(grid), dim3(NWAVES * 64), LDS_BYTES, stream, a);
#endif
}
```

```cpp
#include <hip/hip_runtime.h>
#include <cstdio>
#include <cstdint>
#include <cmath>
namespace pg8 {
#define PG8_LAS __attribute__((address_space(3)))
typedef unsigned short bf16_t;
typedef short bf16x8 __attribute__((ext_vector_type(8)));
typedef float f32x4 __attribute__((ext_vector_type(4)));
typedef unsigned u32x4 __attribute__((ext_vector_type(4)));
constexpr int BM = 256, BK = 64, HALF = 128, HTB = HALF * BK * 2  , STAGE_BYTES = 8 * HTB, NXCD = 8, WGM = 8;

__host__ __device__ __forceinline__ int lds_byte(int r, int c) { const int st = (r >> 4) * 2 + (c >> 5), rr = r & 15, cc = c & 31, ob = rr * 64 + cc * 2; return st * 1024 + (ob ^ (((ob >> 9) & 1) << 5)); }
__host__ __device__ __forceinline__ void stage_rc(int b, int& R, int& C) { const int st = b / 1024, sb = b % 1024, swz = sb ^ (((sb >> 9) & 1) << 5); R = (st >> 1) * 16 + swz / 64; C = (st & 1) * 32 + (swz % 64) / 2; }
__host__ __device__ __forceinline__ int perm32(int rho) { const int n = rho >> 4, i = rho & 15; return 8 * (i >> 2) + 4 * n + (i & 3); }

struct Unit { int pm, pn; };
struct Gemm { const bf16_t* A; const bf16_t* Bt; int M, N, K; };

struct StaticOrder {
    int nM, nN, nwg, G, c, mix;
    __host__ __device__ void init(int M, int N, int G_, int c_) { nM = M / BM; nN = N / BM; nwg = nM * nN; G = G_; c = c_; mix = 0; }
    __host__ __device__ __forceinline__ bool next(int i, Unit& u) const {
        const long L = (long)i * G + c; if (L >= nwg) return false;
        int wgid = (int)L; { const int q = nwg / NXCD, r = nwg % NXCD, xcd = wgid % NXCD, off = wgid / NXCD; wgid = (xcd < r ? xcd * (q + 1) : r * (q + 1) + (xcd - r) * q) + off; }
        const int nig = WGM * nN, gid = wgid / nig, fm = gid * WGM, gsz = (nM - fm) < WGM ? (nM - fm) : WGM;
        u.pm = fm + ((wgid % nig) % gsz); u.pn = (wgid % nig) / gsz;
        if (mix) { const int h = u.pn / 56, i = u.pn - 56 * h, g7 = i / 7, j7 = i - 7 * g7;
            u.pn = (j7 & 1) ? 64 + 24 * h + 3 * g7 + (j7 >> 1) : 32 * h + 4 * g7 + (j7 >> 1); }
        return true;
    }
    __device__ __forceinline__ void a_ready(const Unit&) const {}
    __device__ __forceinline__ void done(const Unit&) const {}
};
typedef __bf16 bf16x2v __attribute__((ext_vector_type(2)));
typedef float f32x2v __attribute__((ext_vector_type(2)));
typedef unsigned u32x2 __attribute__((ext_vector_type(2)));
__device__ __forceinline__ unsigned cvt_pk_bf16(float lo, float hi) { f32x2v v = {lo, hi}; bf16x2v b = __builtin_convertvector(v, bf16x2v); return __builtin_bit_cast(unsigned, b); }
__device__ __forceinline__ float bflo(unsigned w) { return __uint_as_float(w << 16); }
__device__ __forceinline__ float bfhi(unsigned w) { return __uint_as_float(w & 0xffff0000u); }
__device__ __forceinline__ float sigmoidf_(float x) { return __builtin_amdgcn_rcpf(1.0f + __builtin_amdgcn_exp2f(-1.4426950408889634f * x)); }
__device__ __forceinline__ u32x4 pack8(const f32x4& v0, const f32x4& v1) { u32x4 w; w.x = cvt_pk_bf16(v0[0], v0[1]); w.y = cvt_pk_bf16(v0[2], v0[3]); w.z = cvt_pk_bf16(v1[0], v1[1]); w.w = cvt_pk_bf16(v1[2], v1[3]); return w; }

__device__ __forceinline__ unsigned q8_(float g) { return (unsigned)__builtin_fminf(g * 256.0f, 255.0f); }
__device__ __forceinline__ f32x2v gq2_(float a, float b) {
    const f32x2v x = {__builtin_amdgcn_fmed3f(a, -6.5f, 6.5f), __builtin_amdgcn_fmed3f(b, -6.5f, 6.5f)}; const f32x2v x2 = x * x;
    f32x2v p = x2 * (256.0f * 1.693533924e-10f) + (256.0f * -2.709654433e-08f);
    p = p * x2 + (256.0f * 1.777740446e-06f); p = p * x2 + (256.0f * -6.258466407e-05f); p = p * x2 + (256.0f * 1.324479733e-03f);
    p = p * x2 + (256.0f * -1.883604263e-02f); p = p * x2 + (256.0f * 2.483712057e-01f);
    const f32x2v y = p * x + 127.5f; return y + 12582912.0f;
}
__device__ __forceinline__ unsigned gpk4_(const f32x4& v) { const f32x2v a = gq2_(v[0], v[1]), b = gq2_(v[2], v[3]);
    return __builtin_amdgcn_perm(__float_as_uint(a.y), __float_as_uint(a.x), 0x0c0c0400u) | (__builtin_amdgcn_perm(__float_as_uint(b.y), __float_as_uint(b.x), 0x0c0c0400u) << 16); }
struct EpiProj {
    static constexpr bool PERM = true, AFTER_DRAIN = false, HAS_MID = false; static constexpr int MID0 = -1, MID1 = -1;
    bf16_t* O; int ldc; const float* rstd_g;
    PG8_LAS const float* rt;
    unsigned char* G8; int ldg, gate_pn0;
    __device__ __forceinline__ float row_scale(const Unit&, int row, int rloc) const { return rstd_g ? rstd_g[row] : rt[rloc]; }
    __device__ __forceinline__ void operator()(const f32x4 (&acc)[2][2][4][2], const Unit& u, int wr, int wc, int fr, int fq) const {
        const int rl0 = wr * 64 + fr, row0 = u.pm * BM + rl0;
        if (u.pn < gate_pn0) {
            const int col0 = u.pn * BM + wc * 32 + 8 * fq;
#pragma unroll
            for (int ai = 0; ai < 2; ++ai)
#pragma unroll
                for (int m = 0; m < 4; ++m) { const int row = row0 + ai * HALF + m * 16; const float rs = row_scale(u, row, rl0 + ai * HALF + m * 16); bf16_t* rowp = O + (size_t)row * ldc + col0;
#pragma unroll
                    for (int bj = 0; bj < 2; ++bj) { const f32x4 v0 = acc[ai][bj][m][0] * rs, v1 = acc[ai][bj][m][1] * rs; *(u32x4*)(rowp + bj * HALF) = pack8(v0, v1); } }
        } else {
            const int col0 = (u.pn - gate_pn0) * BM + wc * 32 + 8 * fq;
#pragma unroll
            for (int ai = 0; ai < 2; ++ai)
#pragma unroll
                for (int m = 0; m < 4; ++m) { const int row = row0 + ai * HALF + m * 16; const float rs = row_scale(u, row, rl0 + ai * HALF + m * 16); unsigned char* rowp = G8 + (size_t)row * ldg + col0;
#pragma unroll
                    for (int bj = 0; bj < 2; ++bj) { const f32x4 v0 = acc[ai][bj][m][0] * rs, v1 = acc[ai][bj][m][1] * rs; u32x2 w;
                        w.x = gpk4_(v0); w.y = gpk4_(v1);
                        *(u32x2*)(rowp + bj * HALF) = w; } }
        }
    }
};
__device__ __forceinline__ int perm16(int k) { return 8 * ((k >> 2) & 1) + 4 * (k >> 3) + (k & 3); }
__device__ __forceinline__ float ub_(unsigned w, int k) { return (float)((w >> (8 * k)) & 0xffu) + 0.5f; }
struct EpiUpF {
    static constexpr bool PERM = true, AFTER_DRAIN = false, HAS_MID = true; static constexpr int MID0 = 32, MID1 = 64;
    const unsigned char* G; int ldg, gstride; bf16_t* UB; int ldu;
    __device__ __forceinline__ void mid(f32x4 (&acc)[2][2][4][2], const Unit& u, bool second, int wr, int wc, int fr, int fq) const {
        const __amdgpu_buffer_rsrc_t rs = __builtin_amdgcn_make_buffer_rsrc((void*)G, 0, 0x7fffffff, 0x00020000);
        const int voff = (u.pm * BM + wr * 64 + fr) * ldg + u.pn * BM + wc * 32 + 8 * fq; const int sbase = second ? gstride : 0;
#pragma unroll
        for (int ai = 0; ai < 2; ++ai) {
            u32x2 ga[4][2], gb[4][2];
#pragma unroll
            for (int m = 0; m < 4; ++m)
#pragma unroll
                for (int bj = 0; bj < 2; ++bj) { const int so = sbase + (ai * HALF + m * 16) * ldg + bj * HALF;
                    ga[m][bj] = __builtin_amdgcn_raw_buffer_load_b64(rs, voff, so, 0); gb[m][bj] = __builtin_amdgcn_raw_buffer_load_b64(rs, voff, so + gstride, 0); }
#pragma unroll
            for (int m = 0; m < 4; ++m)
#pragma unroll
                for (int bj = 0; bj < 2; ++bj) { const u32x2 a = ga[m][bj], b = gb[m][bj];
                    const f32x4 r0 = {ub_(a.x, 0) * __builtin_amdgcn_rcpf(ub_(b.x, 0)), ub_(a.x, 1) * __builtin_amdgcn_rcpf(ub_(b.x, 1)), ub_(a.x, 2) * __builtin_amdgcn_rcpf(ub_(b.x, 2)), ub_(a.x, 3) * __builtin_amdgcn_rcpf(ub_(b.x, 3))};
                    acc[ai][bj][m][0] = acc[ai][bj][m][0] * r0;
                    const f32x4 r1 = {ub_(a.y, 0) * __builtin_amdgcn_rcpf(ub_(b.y, 0)), ub_(a.y, 1) * __builtin_amdgcn_rcpf(ub_(b.y, 1)), ub_(a.y, 2) * __builtin_amdgcn_rcpf(ub_(b.y, 2)), ub_(a.y, 3) * __builtin_amdgcn_rcpf(ub_(b.y, 3))};
                    acc[ai][bj][m][1] = acc[ai][bj][m][1] * r1; }
            asm volatile("" ::: "memory"); }
    }
    __device__ __forceinline__ void operator()(const f32x4 (&acc)[2][2][4][2], const Unit& u, int wr, int wc, int fr, int fq) const {
        const __amdgpu_buffer_rsrc_t rs = __builtin_amdgcn_make_buffer_rsrc((void*)G, 0, 0x7fffffff, 0x00020000);
        const int row0 = u.pm * BM + wr * 64 + fr, col0 = u.pn * BM + wc * 32 + 8 * fq; const int voff = row0 * ldg + col0;
#pragma unroll
        for (int ai = 0; ai < 2; ++ai) {
            u32x2 gwv[4][2];
#pragma unroll
            for (int m = 0; m < 4; ++m)
#pragma unroll
                for (int bj = 0; bj < 2; ++bj) gwv[m][bj] = __builtin_amdgcn_raw_buffer_load_b64(rs, voff, 2 * gstride + (ai * HALF + m * 16) * ldg + bj * HALF, 0);
#pragma unroll
            for (int m = 0; m < 4; ++m) { const int row = row0 + ai * HALF + m * 16;
#pragma unroll
                for (int bj = 0; bj < 2; ++bj) { const int col = col0 + bj * HALF; const u32x2 gw = gwv[m][bj]; const float k = 1.0f / 256.0f;
                    const f32x4 g0 = {ub_(gw.x, 0) * k, ub_(gw.x, 1) * k, ub_(gw.x, 2) * k, ub_(gw.x, 3) * k}, g1 = {ub_(gw.y, 0) * k, ub_(gw.y, 1) * k, ub_(gw.y, 2) * k, ub_(gw.y, 3) * k};
                    *(u32x4*)(UB + (size_t)row * ldu + col) = pack8(acc[ai][bj][m][0] * g0, acc[ai][bj][m][1] * g1); } }
            asm volatile("" ::: "memory"); }
    }
};
struct EpiOut {
    static constexpr bool PERM = true, AFTER_DRAIN = false, HAS_MID = false; static constexpr int MID0 = -1, MID1 = -1;
    bf16_t* xb; float* ssqp; int ldc;
    __device__ __forceinline__ void operator()(const f32x4 (&acc)[2][2][4][2], const Unit& u, int wr, int wc, int fr, int fq) const {
        const int row0 = u.pm * BM + wr * 64 + fr, col0 = u.pn * BM + wc * 32 + 8 * fq;
#pragma unroll
        for (int ai = 0; ai < 2; ++ai)
#pragma unroll
            for (int m = 0; m < 4; ++m) { const int row = row0 + ai * HALF + m * 16; float ss = 0.f;
#pragma unroll
                for (int bj = 0; bj < 2; ++bj) { const size_t off = (size_t)row * ldc + col0 + bj * HALF; const u32x4 xo = *(const u32x4*)(xb + off);
                    const f32x4 v0 = (f32x4){bflo(xo.x), bfhi(xo.x), bflo(xo.y), bfhi(xo.y)} + acc[ai][bj][m][0], v1 = (f32x4){bflo(xo.z), bfhi(xo.z), bflo(xo.w), bfhi(xo.w)} + acc[ai][bj][m][1];
                    *(u32x4*)(xb + off) = pack8(v0, v1);
                    ss += (v0[0] * v0[0] + v0[1] * v0[1]) + (v0[2] * v0[2] + v0[3] * v0[3]) + (v1[0] * v1[0] + v1[1] * v1[1]) + (v1[2] * v1[2] + v1[3] * v1[3]); }
                ss += __shfl_xor(ss, 16); ss += __shfl_xor(ss, 32);
                if (fq == 0) ssqp[(size_t)row * 64 + u.pn * 4 + wc] = ss; }
    }
};

template <class Epi, class Sched, bool ALIGN_EPI = false, bool SP2 = false>
__device__ __forceinline__ void gemm_phase(PG8_LAS unsigned char* lds, const Gemm g, const Sched& S, const Epi& E) {
    int tid = threadIdx.x; asm volatile("" : "+v"(tid)); const int wid = __builtin_amdgcn_readfirstlane(tid >> 6), lane = tid & 63, wr = wid >> 2, wc = wid & 3, fr = lane & 15, fq = lane >> 4;
    const int K = g.K, nt = K / BK;
    unsigned voffA[2], voffB[2];
#pragma unroll
    for (int i = 0; i < 2; ++i) { int R, C; stage_rc(tid * 16 + i * 8192, R, C); const int Rb = Epi::PERM ? ((R & ~31) + perm32(R & 31)) : R;
        voffA[i] = (unsigned)(R * K + C) * 2u; voffB[i] = (unsigned)(Rb * K + C) * 2u; }
    const size_t kstep = (size_t)(BK * 2);
    const size_t hstep = (size_t)HALF * K * 2;
    const size_t tstep = 2 * hstep;
    const unsigned ldsw = (unsigned)wid * 1024u;
    const int aoff = lds_byte(wr * 64 + fr, fq * 8), boff = lds_byte(wc * 32 + fr, fq * 8);
#define PG8_SA(b, h) (((b) * 2 + (h)) * HTB)
#define PG8_SB(b, h) ((4 + (b) * 2 + (h)) * HTB)
#define PG8_STAGE(bufoff, gbase, voff) do { _Pragma("unroll") for (int _i = 0; _i < 2; ++_i) \
        __builtin_amdgcn_global_load_lds((const unsigned*)((const char*)(gbase) + (voff)[_i]), (PG8_LAS unsigned*)(lds + (bufoff) + ldsw + _i * 8192), 16, 0, PG8_AAUX); } while (0)
#ifndef PG8_BAUX
#define PG8_BAUX 0
#endif
#ifndef PG8_AAUX
#define PG8_AAUX 0
#endif
#define PG8_STAGEB(bufoff, gbase, voff) do { _Pragma("unroll") for (int _i = 0; _i < 2; ++_i) \
        __builtin_amdgcn_global_load_lds((const unsigned*)((const char*)(gbase) + (voff)[_i]), (PG8_LAS unsigned*)(lds + (bufoff) + ldsw + _i * 8192), 16, 0, PG8_BAUX); } while (0)
#define PG8_LDA(dst, b, h) do { _Pragma("unroll") for (int m = 0; m < 4; ++m) _Pragma("unroll") for (int k = 0; k < 2; ++k) dst[m][k] = *(const PG8_LAS bf16x8*)(lds + PG8_SA(b, h) + aoff + m * 2048 + k * 1024); } while (0)
#define PG8_LDB(dst, b, h) do { _Pragma("unroll") for (int n = 0; n < 2; ++n) _Pragma("unroll") for (int k = 0; k < 2; ++k) dst[n][k] = *(const PG8_LAS bf16x8*)(lds + PG8_SB(b, h) + boff + n * 2048 + k * 1024); } while (0)
#define PG8_MMA(ai, bj, At, Bt) do { __builtin_amdgcn_s_setprio(1); _Pragma("unroll") for (int m = 0; m < 4; ++m) _Pragma("unroll") for (int n = 0; n < 2; ++n) _Pragma("unroll") for (int k = 0; k < 2; ++k) \
        acc[ai][bj][m][n] = __builtin_amdgcn_mfma_f32_16x16x32_bf16(Bt[n][k], At[m][k], acc[ai][bj][m][n], 0, 0, 0); __builtin_amdgcn_s_setprio(0); } while (0)
#define PG8_WAIT_V(n) asm volatile("s_waitcnt vmcnt(" #n ")" ::: "memory")
#define PG8_WAIT_L(n) asm volatile("s_waitcnt lgkmcnt(" #n ")" ::: "memory")
#define PG8_BAR __builtin_amdgcn_s_barrier()
#define PG8_SCHED __builtin_amdgcn_sched_barrier(0)
    Unit cur, nxt; int ui = 0;
    if (!S.next(0, cur)) return;
    f32x4 acc[2][2][4][2];
#pragma unroll
    for (int a = 0; a < 2; ++a)
#pragma unroll
        for (int b = 0; b < 2; ++b)
#pragma unroll
            for (int m = 0; m < 4; ++m)
#pragma unroll
                for (int n = 0; n < 2; ++n) acc[a][b][m][n] = (f32x4){0.f, 0.f, 0.f, 0.f};
    bf16x8 At[4][2], B0[2][2], B1[2][2];
    const char* cA = (const char*)g.A + (size_t)cur.pm * tstep; const char* cB = (const char*)g.Bt + (size_t)cur.pn * tstep;
    S.a_ready(cur);
    if constexpr (SP2) {
        PG8_STAGEB(PG8_SB(0, 0), cB, voffB); PG8_STAGEB(PG8_SB(0, 1), cB + hstep, voffB); PG8_STAGE(PG8_SA(0, 0), cA, voffA); PG8_STAGE(PG8_SA(0, 1), cA + hstep, voffA);
        if (wr == 1) PG8_BAR;
        PG8_WAIT_V(2); PG8_BAR;
        PG8_STAGEB(PG8_SB(1, 0), cB + kstep, voffB); PG8_STAGE(PG8_SA(1, 0), cA + kstep, voffA); PG8_STAGEB(PG8_SB(1, 1), cB + hstep + kstep, voffB);
        PG8_WAIT_V(6); PG8_BAR;
    } else {
        PG8_STAGEB(PG8_SB(0, 0), cB, voffB); PG8_STAGE(PG8_SA(0, 0), cA, voffA); PG8_STAGEB(PG8_SB(0, 1), cB + hstep, voffB); PG8_STAGE(PG8_SA(0, 1), cA + hstep, voffA);
        if (wr == 1) PG8_BAR;
        PG8_WAIT_V(4); PG8_BAR;
        PG8_STAGEB(PG8_SB(1, 0), cB + kstep, voffB); PG8_STAGE(PG8_SA(1, 0), cA + kstep, voffA); PG8_STAGEB(PG8_SB(1, 1), cB + hstep + kstep, voffB);
        PG8_WAIT_V(6); PG8_BAR;
    }
    for (;;) {
        const bool has_next = S.next(ui + 1, nxt);
        const char* nA = has_next ? (const char*)g.A + (size_t)nxt.pm * tstep : cA; const char* nB = has_next ? (const char*)g.Bt + (size_t)nxt.pn * tstep : cB;
        for (int t = 0; t < nt; t += 2) {
            const bool last = (t == nt - 2);
            const char* a1 = cA + (size_t)(t + 1) * kstep;
            const char* a2 = last ? nA : cA + (size_t)(t + 2) * kstep; const char* b2 = last ? nB : cB + (size_t)(t + 2) * kstep;
            const char* a3 = a2 + kstep; const char* b3 = b2 + kstep;
            if (last && has_next) S.a_ready(nxt);
            if constexpr (Epi::HAS_MID) { if (t == Epi::MID0 || t == Epi::MID1) E.mid(acc, cur, t == Epi::MID1, wr, wc, fr, fq); }
            if constexpr (SP2) {
            PG8_LDB(B0, 0, 0); PG8_LDB(B1, 0, 1); PG8_SCHED; PG8_LDA(At, 0, 0); PG8_STAGE(PG8_SA(1, 1), a1 + hstep, voffA);
            PG8_WAIT_V(8); PG8_WAIT_L(0); PG8_BAR; PG8_MMA(0, 0, At, B0); PG8_MMA(0, 1, At, B1); PG8_BAR; PG8_SCHED;
            PG8_LDA(At, 0, 1); PG8_STAGEB(PG8_SB(0, 0), b2, voffB); PG8_STAGEB(PG8_SB(0, 1), b2 + hstep, voffB); PG8_STAGE(PG8_SA(0, 0), a2, voffA);
            PG8_WAIT_V(8); PG8_WAIT_L(0); PG8_BAR; PG8_MMA(1, 0, At, B0); PG8_MMA(1, 1, At, B1); PG8_BAR; PG8_SCHED;
            PG8_LDB(B0, 1, 0); PG8_LDB(B1, 1, 1); PG8_SCHED; PG8_LDA(At, 1, 0); PG8_STAGE(PG8_SA(0, 1), a2 + hstep, voffA);
            PG8_WAIT_V(8); PG8_WAIT_L(0); PG8_BAR; PG8_MMA(0, 0, At, B0); PG8_MMA(0, 1, At, B1); PG8_BAR; PG8_SCHED;
            PG8_LDA(At, 1, 1); PG8_STAGEB(PG8_SB(1, 0), b3, voffB); PG8_STAGEB(PG8_SB(1, 1), b3 + hstep, voffB); PG8_STAGE(PG8_SA(1, 0), a3, voffA);
            PG8_WAIT_V(8); PG8_WAIT_L(0); PG8_BAR; PG8_MMA(1, 0, At, B0); PG8_MMA(1, 1, At, B1); PG8_BAR; PG8_SCHED;
            } else {
            PG8_LDB(B0, 0, 0); PG8_SCHED; PG8_LDA(At, 0, 0); PG8_STAGE(PG8_SA(1, 1), a1 + hstep, voffA);
            PG8_WAIT_L(8); PG8_BAR; PG8_WAIT_L(0); PG8_MMA(0, 0, At, B0); PG8_BAR; PG8_SCHED;
            PG8_LDB(B1, 0, 1); PG8_STAGEB(PG8_SB(0, 0), b2, voffB);
            PG8_BAR; PG8_WAIT_L(0); PG8_MMA(0, 1, At, B1); PG8_BAR;
            PG8_LDA(At, 0, 1); PG8_STAGE(PG8_SA(0, 0), a2, voffA);
            PG8_BAR; PG8_WAIT_L(0); PG8_MMA(1, 0, At, B0); PG8_BAR; PG8_SCHED;
            PG8_STAGEB(PG8_SB(0, 1), b2 + hstep, voffB);
            PG8_WAIT_V(6); PG8_BAR; PG8_MMA(1, 1, At, B1); PG8_BAR;
            PG8_LDB(B0, 1, 0); PG8_SCHED; PG8_LDA(At, 1, 0); PG8_STAGE(PG8_SA(0, 1), a2 + hstep, voffA);
            PG8_WAIT_L(8); PG8_BAR; PG8_WAIT_L(0); PG8_MMA(0, 0, At, B0); PG8_BAR; PG8_SCHED;
            PG8_LDB(B1, 1, 1); PG8_STAGEB(PG8_SB(1, 0), b3, voffB);
            PG8_BAR; PG8_WAIT_L(0); PG8_MMA(0, 1, At, B1); PG8_BAR;
            PG8_LDA(At, 1, 1); PG8_STAGE(PG8_SA(1, 0), a3, voffA);
            PG8_BAR; PG8_WAIT_L(0); PG8_MMA(1, 0, At, B0); PG8_BAR; PG8_SCHED;
            PG8_STAGEB(PG8_SB(1, 1), b3 + hstep, voffB);
            PG8_WAIT_V(6); PG8_BAR; PG8_MMA(1, 1, At, B1); PG8_BAR;
            }
        }
        if constexpr (ALIGN_EPI) { if (wr == 0) PG8_BAR; }
        if constexpr (!Epi::AFTER_DRAIN) { E(acc, cur, wr, wc, fr, fq); S.done(cur); }
        if (!has_next) break;
#pragma unroll
        for (int a = 0; a < 2; ++a)
#pragma unroll
            for (int b = 0; b < 2; ++b)
#pragma unroll
                for (int m = 0; m < 4; ++m)
#pragma unroll
                    for (int n = 0; n < 2; ++n) acc[a][b][m][n] = (f32x4){0.f, 0.f, 0.f, 0.f};
        cur = nxt; cA = nA; cB = nB; ++ui;
        if constexpr (ALIGN_EPI) { if (wr == 1) PG8_BAR; }
    }
    PG8_WAIT_V(0);
    if constexpr (!ALIGN_EPI) { if (wr == 0) PG8_BAR; }
    PG8_BAR;
    if constexpr (Epi::AFTER_DRAIN) { E.fused(acc, cur, wr, wc, fr, fq, lds, wid, lane); S.done(cur); }
#undef PG8_SA
#undef PG8_SB
#undef PG8_STAGE
#undef PG8_STAGEB
#undef PG8_LDA
#undef PG8_LDB
#undef PG8_MMA
#undef PG8_WAIT_V
#undef PG8_WAIT_L
#undef PG8_BAR
#undef PG8_SCHED
}
}

#define LAS __attribute__((address_space(3)))
typedef unsigned short bf16;
typedef short bf16x8 __attribute__((ext_vector_type(8)));
typedef float f32x4 __attribute__((ext_vector_type(4)));
typedef float f32x16 __attribute__((ext_vector_type(16)));
typedef unsigned u32x4 __attribute__((ext_vector_type(4)));
typedef unsigned u32x2 __attribute__((ext_vector_type(2)));
using pg8::cvt_pk_bf16; using pg8::bflo; using pg8::bfhi; using pg8::sigmoidf_; using pg8::perm16;

constexpr int DM = 4096, NBAT = 4, SEQ = 2048, NLAY = 4, TOK = NBAT * SEQ, HD = 128;
constexpr int NP = 28672;
constexpr int C_AH = 0, C_AB = 2048, C_AC = 4096, C_AZ = 6144, C_NQ = 8192, C_KV = 10240, C_NZ = 13312, C_XQ = 15360, C_XZ = 15872, C_MG = 16384;
constexpr int INW = 28720, S_NG = 13312, S_NZ = 13360;
constexpr float EPS = 1e-6f;
constexpr int NWAVES = 8;

constexpr size_t CTL_BYTES = 1u << 20;
constexpr size_t WS_WIN = CTL_BYTES;
constexpr int YK = 4608;
constexpr size_t WS_WUP = WS_WIN + (size_t)NLAY * NP * DM * 2;
constexpr size_t WS_WO = WS_WUP + (size_t)NLAY * DM * YK * 2;
constexpr size_t WS_WMKV = WS_WO + (size_t)NLAY * DM * DM * 2;
constexpr size_t WS_W1 = WS_WMKV + (size_t)4096 * DM * 2;
constexpr size_t WS_W2 = WS_W1 + (size_t)NLAY * 2 * 128 * 4096 * 2;
constexpr size_t WS_PB = WS_W2 + (size_t)NLAY * 2 * 128 * 128 * 2;
constexpr size_t WS_COS = WS_PB + 4096;
constexpr size_t WS_SIN = WS_COS + (size_t)SEQ * 64 * 4;
constexpr size_t WS_XB = WS_SIN + (size_t)SEQ * 64 * 4;
constexpr size_t WS_MEMB = WS_XB + (size_t)TOK * DM * 2;
constexpr size_t WS_RSTDM = WS_MEMB + (size_t)1024 * DM * 2;
constexpr size_t WS_SSQP = WS_RSTDM + 4096;
constexpr size_t WS_RSTD = WS_SSQP + (size_t)TOK * 64 * 4;
constexpr size_t WS_P = WS_RSTD + (size_t)TOK * 4;
constexpr size_t WS_MEMK = WS_P + (size_t)TOK * NP * 2;
constexpr size_t WS_MEMVT = WS_MEMK + (size_t)1024 * 4096 * 2;
constexpr size_t WS_KR = WS_MEMVT + (size_t)NLAY * 16 * 256 * 128 * 2;
constexpr size_t WS_VT = WS_KR + (size_t)2 * 16 * SEQ * 128 * 2;
constexpr size_t WS_KC = WS_VT + (size_t)2 * 16 * SEQ * 128 * 2;
constexpr size_t WS_VTC = WS_KC + (size_t)16 * 128 * 128 * 2;
constexpr size_t WS_Y = WS_VTC + (size_t)16 * 128 * 128 * 2;
constexpr size_t WS_UB = WS_Y + (size_t)TOK * YK * 2;
constexpr size_t WS_MEMK2 = WS_UB + (size_t)TOK * DM * 2;
constexpr size_t WS_WG = WS_MEMK2 + (size_t)NLAY * 16 * 256 * 128 * 2;
constexpr size_t WS_NG = WS_WG + (size_t)NLAY * 64 * DM * 2;
constexpr size_t WS_TSC = WS_NG + (size_t)TOK * 48 * 4;
constexpr size_t WS_G8 = WS_TSC + (size_t)320 * 8 * 32 * 64 * 4;
constexpr size_t WS_END = WS_G8 + (size_t)TOK * 3 * DM;
constexpr int CW_Q = 12288;
constexpr int CW_BAR = 4096;

constexpr int RING_BYTES = 131072, MISC_OFF = RING_BYTES + 320, RT_OFF = RING_BYTES + 2048  , LDS_BYTES = 147456;
constexpr int A_KB0 = 0, A_KB1 = 16384, A_VB0 = 32768, A_VB1 = 49152, A_IMPW = 65536;
constexpr int A_IMPS = A_IMPW + 8 * 32 * 33 * 4, A_SELM = A_IMPS + 64 * 33 * 4, A_END = A_SELM + 256;
static_assert(A_END <= RING_BYTES, "attention LDS map");

#define LDS_WAIT() asm volatile("s_waitcnt lgkmcnt(0)" ::: "memory")
__device__ __forceinline__ int bx_now() { int b = blockIdx.x; asm volatile("" : "+s"(b)); return b; }
__device__ __forceinline__ int tid_now() { int t = threadIdx.x; asm volatile("" : "+v"(t)); return t; }
__device__ __forceinline__ float bf2f(bf16 v) { return __uint_as_float(((unsigned)v) << 16); }
__device__ __forceinline__ bf16 f2bf(float f) { return (bf16)(cvt_pk_bf16(f, 0.f) & 0xffffu); }
__device__ __forceinline__ float wave_sum(float v) {
#pragma unroll
    for (int o = 1; o < 64; o <<= 1) v += __shfl_xor(v, o);
    return v;
}
__device__ __forceinline__ float siluf_(float x) { return x * sigmoidf_(x); }

#define XB_TMO      128
#define XB_XCNT(j)  (256  + 64 * (j))
#define XB_XSUB(j)  (1280 + 64 * (j))
#define XB_XGEN(j)  (2304 + 64 * (j))
#define XB_TOP      3328
#define XB_TOPGEN   3392
#define XCD_BAR_WORDS 3456
#define XB_SPIN_CAP (1u << 22)
__device__ __forceinline__ unsigned xb_ld(unsigned* p)              { return __hip_atomic_load(p, __ATOMIC_RELAXED, __HIP_MEMORY_SCOPE_AGENT); }
__device__ __forceinline__ unsigned xb_add(unsigned* p, unsigned v) { return __hip_atomic_fetch_add(p, v, __ATOMIC_RELAXED, __HIP_MEMORY_SCOPE_AGENT); }
__device__ __forceinline__ unsigned xb_xcc_id() { return (unsigned)__builtin_amdgcn_s_getreg((3 << 11) | 20) & 0xFu; }
#define XB_SPIN(cond, bar) do { unsigned _sp = 0; while (cond) { __builtin_amdgcn_s_sleep(1); \
    if ((++_sp & 255u) == 0u) { if (xb_ld(&(bar)[XB_TMO])) break; if (_sp > XB_SPIN_CAP) { atomicAdd(&(bar)[XB_TMO], 1u); break; } } } } while (0)
struct XcdBarrier { unsigned* bar; unsigned x; volatile LAS unsigned* st; };
__device__ __forceinline__ XcdBarrier xcd_barrier_post(unsigned* bar, volatile LAS unsigned* st) {
    XcdBarrier b; b.bar = bar; b.x = xb_xcc_id(); b.st = st;
    if (threadIdx.x == 0) (void)xb_add(&bar[XB_XCNT(b.x)], 1u);
    return b;
}
__device__ __forceinline__ void xcd_barrier_complete(unsigned* bar, unsigned x, unsigned& nloc, unsigned& nx) {
    const unsigned G = gridDim.x * gridDim.y * gridDim.z;
    unsigned sum, cnt, mine, sp = 0u;
    for (;;) {
        sum = 0u; cnt = 0u; mine = 0u;
#pragma unroll
        for (unsigned j = 0; j < 16; ++j) { const unsigned c = xb_ld(&bar[XB_XCNT(j)]); sum += c; cnt += (c > 0u) ? 1u : 0u; mine = (j == x) ? c : mine; }
        if (sum == G) break;
        __builtin_amdgcn_s_sleep(1);
        if ((++sp & 255u) == 0u) { if (xb_ld(&bar[XB_TMO])) break; if (sp > XB_SPIN_CAP) { atomicAdd(&bar[XB_TMO], 1u); break; } }
    }
    nloc = mine > 0u ? mine : 1u; nx = cnt > 0u ? cnt : 1u;
}
__device__ __forceinline__ void xcd_barrier(const XcdBarrier& b) {
    asm volatile("s_waitcnt vmcnt(0)" ::: "memory");
    __syncthreads();
    if (threadIdx.x == 0) {
        unsigned* bar = b.bar;
        __builtin_amdgcn_s_waitcnt(0);
        unsigned nloc = b.st[0], nx = b.st[1];
        if (nloc == 0u) { xcd_barrier_complete(bar, b.x, nloc, nx); b.st[0] = nloc; b.st[1] = nx; }
        const unsigned old = xb_add(&bar[XB_XSUB(b.x)], 1u);
        const unsigned gen = old / nloc;
        if (old + 1u == (gen + 1u) * nloc) {
            __builtin_amdgcn_fence(__ATOMIC_RELEASE, "agent");
            asm volatile("s_waitcnt vmcnt(0)" ::: "memory");
            const unsigned og = xb_add(&bar[XB_TOP], 1u);
            const unsigned tg = og / nx;
            if (og + 1u == (tg + 1u) * nx) xb_add(&bar[XB_TOPGEN], 1u);
            else XB_SPIN(xb_ld(&bar[XB_TOPGEN]) == tg, bar);
            __builtin_amdgcn_fence(__ATOMIC_ACQUIRE, "agent");
            xb_add(&bar[XB_XGEN(b.x)], 1u);
            asm volatile("s_waitcnt vmcnt(0)" ::: "memory");
        } else {
            XB_SPIN(xb_ld(&bar[XB_XGEN(b.x)]) == gen, bar);
            __builtin_amdgcn_fence(__ATOMIC_ACQUIRE, "agent");
            asm volatile("s_waitcnt vmcnt(0)" ::: "memory");
        }
    }
    __syncthreads();
}

struct Ctx {
    const float *x, *mem, *norm_g, *w_in, *conv_w, *conv_b, *cmp_pos, *cmp_w1, *cmp_w2, *mem_norm_g, *w_mem_kv, *w_up_a, *w_up_b, *w_up_x, *w_out, *final_g;
    float* out;
    unsigned char* ws;
    int G, vcu;
    __device__ __forceinline__ bf16* Win_t() const { return (bf16*)(ws + WS_WIN); }
    __device__ __forceinline__ bf16* Wup_t() const { return (bf16*)(ws + WS_WUP); }
    __device__ __forceinline__ bf16* Wo_t() const { return (bf16*)(ws + WS_WO); }
    __device__ __forceinline__ bf16* Wmkv_t() const { return (bf16*)(ws + WS_WMKV); }
    __device__ __forceinline__ bf16* W1_t() const { return (bf16*)(ws + WS_W1); }
    __device__ __forceinline__ bf16* W2_t() const { return (bf16*)(ws + WS_W2); }
    __device__ __forceinline__ float* pb() const { return (float*)(ws + WS_PB); }
    __device__ __forceinline__ float* cost() const { return (float*)(ws + WS_COS); }
    __device__ __forceinline__ float* sint() const { return (float*)(ws + WS_SIN); }
    __device__ __forceinline__ float* rstdm() const { return (float*)(ws + WS_RSTDM); }
    __device__ __forceinline__ float* ssqp() const { return (float*)(ws + WS_SSQP); }
    __device__ __forceinline__ float* rstd() const { return (float*)(ws + WS_RSTD); }
    __device__ __forceinline__ bf16* xb() const { return (bf16*)(ws + WS_XB); }
    __device__ __forceinline__ bf16* memb() const { return (bf16*)(ws + WS_MEMB); }
    __device__ __forceinline__ bf16* P() const { return (bf16*)(ws + WS_P); }
    __device__ __forceinline__ bf16* MKV() const { return (bf16*)(ws + WS_MEMK); }
    __device__ __forceinline__ bf16* memK() const { return (bf16*)(ws + WS_MEMK2); }
    __device__ __forceinline__ bf16* memVt() const { return (bf16*)(ws + WS_MEMVT); }
    __device__ __forceinline__ bf16* Kr() const { return (bf16*)(ws + WS_KR); }
    __device__ __forceinline__ bf16* Vt() const { return (bf16*)(ws + WS_VT); }
    __device__ __forceinline__ bf16* Kc() const { return (bf16*)(ws + WS_KC); }
    __device__ __forceinline__ bf16* Vtc() const { return (bf16*)(ws + WS_VTC); }
    __device__ __forceinline__ bf16* Y() const { return (bf16*)(ws + WS_Y); }
    __device__ __forceinline__ bf16* UB() const { return (bf16*)(ws + WS_UB); }
    __device__ __forceinline__ unsigned* tsc() const { return (unsigned*)(ws + WS_TSC); }
    __device__ __forceinline__ bf16* Wg_t() const { return (bf16*)(ws + WS_WG); }
    __device__ __forceinline__ float* ng() const { return (float*)(ws + WS_NG); }
    __device__ __forceinline__ unsigned char* G8() const { return ws + WS_G8; }
};

struct TrJob { const float* W; const float* gs; bf16* WT; int ldw, k0, ns, nvalid, ldk, nd; };
struct TrRegs { f32x4 v[8]; f32x4 g0, g1; };
__device__ __forceinline__ void tr_load(TrRegs& R, const TrJob& j, int lane) {
    const int col4 = (lane & 7) * 4, r0 = lane >> 3;
#pragma unroll
    for (int i = 0; i < 8; ++i) { f32x4 v = {0.f, 0.f, 0.f, 0.f}; if (col4 < j.nvalid) v = *(const f32x4*)(j.W + (size_t)(j.k0 + 8 * i + r0) * j.ldw + j.ns + col4); R.v[i] = v; }
    R.g0 = (f32x4){1.f, 1.f, 1.f, 1.f}; R.g1 = R.g0;
    if (j.gs) { R.g0 = *(const f32x4*)(j.gs + j.k0 + 8 * (lane & 7)); R.g1 = *(const f32x4*)(j.gs + j.k0 + 8 * (lane & 7) + 4); }
}
__device__ __forceinline__ void tr_store(const TrRegs& R, const TrJob& j, LAS float* scr, int lane) {
    const int col4 = (lane & 7) * 4, r0 = lane >> 3;
#pragma unroll
    for (int i = 0; i < 8; ++i) { LAS float* d = scr + (8 * i + r0) * 33 + col4; d[0] = R.v[i][0]; d[1] = R.v[i][1]; d[2] = R.v[i][2]; d[3] = R.v[i][3]; }
    LDS_WAIT();
    const int c = lane & 7;
#pragma unroll
    for (int jj = 0; jj < 4; ++jj) { const int n = (lane >> 3) + 8 * jj; const LAS float* s = scr + (8 * c) * 33 + n;
        u32x4 o; o.x = cvt_pk_bf16(s[0 * 33] * R.g0[0], s[1 * 33] * R.g0[1]); o.y = cvt_pk_bf16(s[2 * 33] * R.g0[2], s[3 * 33] * R.g0[3]); o.z = cvt_pk_bf16(s[4 * 33] * R.g1[0], s[5 * 33] * R.g1[1]); o.w = cvt_pk_bf16(s[6 * 33] * R.g1[2], s[7 * 33] * R.g1[3]);
        *(u32x4*)(j.WT + (size_t)(j.nd + n) * j.ldk + j.k0 + 8 * c) = o; }
    LDS_WAIT();
}
constexpr int IT_IN1 = 64 * 416, IT_IN2 = 64 * 480, IT_ING = 64 * 2, IT_UA = 32 * 128, IT_UX = 8 * 128, IT_O = 64 * 128, IT_MKV = 64 * 32, IT_W1 = 64 * 4, IT_W2 = 2 * 4;
constexpr int IT_LAYER = IT_IN1 + IT_IN2 + IT_ING + 2 * IT_UA + IT_UX + IT_O + 2 * IT_W1 + 2 * IT_W2;
constexpr int TR_ITEMS = NLAY * IT_LAYER, TRCH = 16;
__device__ __forceinline__ TrJob tr_decode(const Ctx& C, int it) {
    TrJob j; const int l = it / IT_LAYER; int r = it - l * IT_LAYER; j.gs = nullptr; j.nvalid = 32;
    if (r < IT_IN1 + IT_IN2 + IT_ING) { j.W = C.w_in + (size_t)l * DM * INW; j.ldw = INW; j.gs = C.norm_g + l * DM; j.WT = C.Win_t() + (size_t)l * NP * DM; j.ldk = DM;
        if (r < IT_IN1) { j.k0 = 64 * (r / 416); j.ns = 32 * (r % 416); j.nd = j.ns; return j; } r -= IT_IN1;
        if (r < IT_IN2) { j.k0 = 64 * (r / 480); j.ns = S_NZ + 32 * (r % 480); j.nd = C_NZ + 32 * (r % 480); return j; } r -= IT_IN2;
        j.k0 = 64 * (r >> 1); j.ns = S_NG + 32 * (r & 1); j.nvalid = (r & 1) ? 16 : 32; j.WT = C.Wg_t() + (size_t)l * 64 * DM; j.nd = 32 * (r & 1); return j; }
    r -= IT_IN1 + IT_IN2 + IT_ING;
    if (r < IT_UA) { j.W = C.w_up_a + (size_t)l * 2048 * DM; j.ldw = DM; j.k0 = 64 * (r / 128); j.ns = 32 * (r % 128); j.WT = C.Wup_t() + (size_t)l * DM * YK; j.ldk = YK; j.nd = j.ns; return j; } r -= IT_UA;
    if (r < IT_UA) { j.W = C.w_up_b + (size_t)l * 2048 * DM; j.ldw = DM; j.k0 = 64 * (r / 128); j.ns = 32 * (r % 128); j.WT = C.Wup_t() + (size_t)l * DM * YK + 2048; j.ldk = YK; j.nd = j.ns; return j; } r -= IT_UA;
    if (r < IT_UX) { j.W = C.w_up_x + (size_t)l * 512 * DM; j.ldw = DM; j.k0 = 64 * (r / 128); j.ns = 32 * (r % 128); j.WT = C.Wup_t() + (size_t)l * DM * YK + 4096; j.ldk = YK; j.nd = j.ns; return j; } r -= IT_UX;
    if (r < IT_O) { j.W = C.w_out + (size_t)l * DM * DM; j.ldw = DM; j.k0 = 64 * (r / 128); j.ns = 32 * (r % 128); j.WT = C.Wo_t() + (size_t)l * DM * DM; j.ldk = DM; j.nd = j.ns; return j; } r -= IT_O;
    if (r < 2 * IT_W1) { const int c = r / IT_W1; r -= c * IT_W1; j.W = C.cmp_w1 + (size_t)(l * 2 + c) * 4096 * 128; j.ldw = 128; j.k0 = 64 * (r >> 2); j.ns = 32 * (r & 3); j.WT = C.W1_t() + (size_t)(l * 2 + c) * 128 * 4096; j.ldk = 4096; j.nd = j.ns; return j; } r -= 2 * IT_W1;
    { const int c = r / IT_W2; r -= c * IT_W2; j.W = C.cmp_w2 + (size_t)(l * 2 + c) * 128 * 128; j.ldw = 128; j.k0 = 64 * (r >> 2); j.ns = 32 * (r & 3); j.WT = C.W2_t() + (size_t)(l * 2 + c) * 128 * 128; j.ldk = 128; j.nd = j.ns; return j; }
}
__device__ __forceinline__ void p0_prologue(const Ctx& C, LAS unsigned char* lds) {
    const int tid = tid_now(), lane = tid & 63, wave = __builtin_amdgcn_readfirstlane(tid >> 6);
    LAS float* scr = (LAS float*)(lds + wave * 16384);
    const int gw = blockIdx.x * NWAVES + wave, NGW = C.G * NWAVES;
    for (int it = gw; it < NLAY * IT_MKV; it += NGW) { const int l = it / IT_MKV, r = it - l * IT_MKV;
        TrJob j; j.W = C.w_mem_kv + (size_t)l * DM * 1024; j.gs = C.mem_norm_g + l * DM; j.WT = C.Wmkv_t(); j.ldw = 1024; j.k0 = 64 * (r >> 5); j.ns = 32 * (r & 31); j.nvalid = 32; j.ldk = DM; j.nd = l * 1024 + j.ns;
        TrRegs R; tr_load(R, j, lane); tr_store(R, j, scr, lane); }
    for (int row = gw; row < TOK; row += NGW) {
        const f32x4* xr = (const f32x4*)(C.x + (size_t)row * DM) + lane; u32x2* ob = (u32x2*)(C.xb() + (size_t)row * DM) + lane; float ss = 0.f;
#pragma unroll
        for (int j = 0; j < 16; ++j) { const f32x4 v = xr[64 * j]; ss += (v[0] * v[0] + v[1] * v[1]) + (v[2] * v[2] + v[3] * v[3]); u32x2 o; o.x = cvt_pk_bf16(v[0], v[1]); o.y = cvt_pk_bf16(v[2], v[3]); ob[64 * j] = o; }
        C.ssqp()[(size_t)row * 64 + lane] = ss;
    }
    for (int row = gw; row < NBAT * 256; row += NGW) {
        const f32x4* xr = (const f32x4*)(C.mem + (size_t)row * DM) + lane; u32x2* ob = (u32x2*)(C.memb() + (size_t)row * DM) + lane; float ss = 0.f;
#pragma unroll
        for (int j = 0; j < 16; ++j) { const f32x4 v = xr[64 * j]; ss += (v[0] * v[0] + v[1] * v[1]) + (v[2] * v[2] + v[3] * v[3]); u32x2 o; o.x = cvt_pk_bf16(v[0], v[1]); o.y = cvt_pk_bf16(v[2], v[3]); ob[64 * j] = o; }
        ss = wave_sum(ss);
        if (lane == 0) C.rstdm()[row] = 1.0f / sqrtf(ss * (1.0f / DM) + EPS);
    }
}
__device__ __forceinline__ void p0_tables(const Ctx& C) {
    const int tid = tid_now(), lane = tid & 63, wave = __builtin_amdgcn_readfirstlane(tid >> 6);
    const int gw = blockIdx.x * NWAVES + wave, NGW = C.G * NWAVES;
    for (int e = blockIdx.x * 512 + tid; e < SEQ * 64; e += C.G * 512) {
        const int s = e >> 6, i = e & 63;
        double f = 1.0; const double rr = 0.86596432336006535;
        for (int k = 0; k < i; ++k) f *= rr;
        const double a = (double)s * f; const double TWO_PI = 6.283185307179586476925;
        const double kq = __builtin_rint(a / TWO_PI); const double t = a - kq * TWO_PI, t2 = t * t;
        double cs = 1.0, sn = t, term_c = 1.0, term_s = t;
#pragma unroll 1
        for (int k = 1; k <= 13; ++k) { term_c *= -t2 / (double)((2 * k - 1) * (2 * k)); term_s *= -t2 / (double)((2 * k) * (2 * k + 1)); cs += term_c; sn += term_s; }
        C.cost()[e] = (float)cs; C.sint()[e] = (float)sn;
    }
    for (int o = gw; o < NLAY * 2 * 128; o += NGW) {
        const int lc = o >> 7, j = o & 127; const float* pp = C.cmp_pos + (size_t)lc * 4096; const float* ww = C.cmp_w1 + (size_t)lc * 4096 * 128 + j; float s = 0.f;
        { float s1 = 0.f, s2 = 0.f, s3 = 0.f;
#pragma unroll 4
          for (int f = lane; f < 4096; f += 256) { s += pp[f] * ww[(size_t)f * 128]; s1 += pp[f + 64] * ww[(size_t)(f + 64) * 128]; s2 += pp[f + 128] * ww[(size_t)(f + 128) * 128]; s3 += pp[f + 192] * ww[(size_t)(f + 192) * 128]; }
          s = (s + s1) + (s2 + s3); }
        s = wave_sum(s);
        if (lane == 0) C.pb()[o] = s;
    }
}
__device__ __forceinline__ void p0_convert(const Ctx& C, LAS unsigned char* lds, unsigned* qctr) {
    const int tid = tid_now(), lane = tid & 63, wave = __builtin_amdgcn_readfirstlane(tid >> 6);
    LAS float* scr = (LAS float*)(lds + wave * 16384);
    int qcur = 0, qend = 0;
#define TR_NEXT(dst) do { if (qcur == qend) { int b_ = 0; if (lane == 0) b_ = (int)atomicAdd(qctr, (unsigned)TRCH); b_ = __builtin_amdgcn_readfirstlane(b_); qcur = b_; qend = (b_ + TRCH < TR_ITEMS) ? b_ + TRCH : TR_ITEMS; } \
        if (qcur < qend) { dst = qcur; ++qcur; } else { dst = -1; qend = qcur; } } while (0)
    int it; TR_NEXT(it);
    if (it >= 0) {
        TrJob cur = tr_decode(C, it); TrRegs A; tr_load(A, cur, lane);
        for (;;) {
            int nx; TR_NEXT(nx); TrJob nj = cur; TrRegs B = A;
            if (nx >= 0) { nj = tr_decode(C, nx); tr_load(B, nj, lane); }
            tr_store(A, cur, scr, lane);
            if (nx < 0) break;
            cur = nj; A = B;
        }
    }
#undef TR_NEXT
}

__device__ __forceinline__ void rstd_phase(const Ctx& C) {
    const int tid = tid_now(), lane = tid & 63, wave = tid >> 6; const int gw = blockIdx.x * NWAVES + wave, NGW = C.G * NWAVES;
    for (int row0 = gw; row0 < TOK; row0 += 4 * NGW) { float v[4];
#pragma unroll
        for (int k = 0; k < 4; ++k) { const int row = row0 + k * NGW; v[k] = row < TOK ? C.ssqp()[(size_t)row * 64 + lane] : 0.f; }
#pragma unroll
        for (int k = 0; k < 4; ++k) { const int row = row0 + k * NGW; const float s = wave_sum(v[k]); if (lane == 0 && row < TOK) C.rstd()[row] = 1.0f / sqrtf(s * (1.0f / DM) + EPS); } }
}
__device__ __forceinline__ void final_phase(const Ctx& C) {
    const int tid = tid_now(), lane = tid & 63, wave = tid >> 6; const int gw = blockIdx.x * NWAVES + wave, NGW = C.G * NWAVES;
    for (int row = gw; row < TOK; row += NGW) {
        const float s = wave_sum(C.ssqp()[(size_t)row * 64 + lane]); const float rs = 1.0f / sqrtf(s * (1.0f / DM) + EPS);
        const u32x2* xr = (const u32x2*)(C.xb() + (size_t)row * DM) + lane; f32x4* orow = (f32x4*)(C.out + (size_t)row * DM) + lane; const f32x4* gr = (const f32x4*)C.final_g + lane;
#pragma unroll
        for (int j = 0; j < 16; ++j) { const u32x2 xv = xr[64 * j]; const f32x4 v = {bflo(xv.x), bfhi(xv.x), bflo(xv.y), bfhi(xv.y)}; orow[64 * j] = v * rs * gr[64 * j]; }
    }
}

constexpr float SL2 = 0.08838834764831845f * 1.4426950408889634f;
#define MFMA32(a, b, c) __builtin_amdgcn_mfma_f32_32x32x16_bf16((a), (b), (c), 0, 0, 0)
#define MFMA16(a, b, c) __builtin_amdgcn_mfma_f32_16x16x32_bf16((a), (b), (c), 0, 0, 0)
__device__ __forceinline__ void dma_k(LAS unsigned char* kb, const bf16* Kp, int kpitch, int tid, int w) {
#pragma unroll
    for (int q = 0; q < 2; ++q) { const int p = q * 512 + tid, row = p >> 4, c = (p & 15) ^ (row & 15);
        __builtin_amdgcn_global_load_lds((const unsigned*)(Kp + (size_t)row * kpitch + c * 8), (LAS unsigned*)(kb + (q * 512 + w * 64) * 16), 16, 0, 0); }
}
__device__ __forceinline__ void dma_v(LAS unsigned char* vb, const bf16* Vtp, int vts, int tid, int w) {
#pragma unroll
    for (int q = 0; q < 2; ++q) { const int p = q * 512 + tid, d = p >> 3, c = (p & 7) ^ ((d >> 1) & 7);
        __builtin_amdgcn_global_load_lds((const unsigned*)(Vtp + (size_t)d * vts + c * 8), (LAS unsigned*)(vb + (q * 512 + w * 64) * 16), 16, 0, 0); }
}
template <int s> __device__ __forceinline__ bf16x8 pack_step(const f32x16& x) {
    u32x4 p; p.x = cvt_pk_bf16(x[8 * s], x[8 * s + 1]); p.y = cvt_pk_bf16(x[8 * s + 2], x[8 * s + 3]); p.z = cvt_pk_bf16(x[8 * s + 4], x[8 * s + 5]); p.w = cvt_pk_bf16(x[8 * s + 6], x[8 * s + 7]);
    return __builtin_bit_cast(bf16x8, p);
}
__device__ __forceinline__ void qk_tile(f32x16& S0, f32x16& S1, const bf16x8 (&qf)[8], LAS const unsigned char* kb, int lane) {
    const int row = lane & 31, hi = lane >> 5, x = row & 15;
    LAS const unsigned char* kp = kb + row * 256;
#pragma unroll
    for (int r = 0; r < 16; ++r) { S0[r] = 0.f; S1[r] = 0.f; }
#pragma unroll
    for (int st = 0; st < 8; ++st) { const int off = ((2 * st + hi) ^ x) * 16; const bf16x8 k0 = *(LAS const bf16x8*)(kp + off); const bf16x8 k1 = *(LAS const bf16x8*)(kp + 32 * 256 + off);
        S0 = MFMA32(k0, qf[st], S0); S1 = MFMA32(k1, qf[st], S1); }
}
template <int MODE> __device__ __forceinline__ void mask_raw(f32x16& S0, f32x16& S1, int kbase, int tq, int hi) {
    const float NINF = -__builtin_inff();
#pragma unroll
    for (int r = 0; r < 16; ++r) { const int k0 = kbase + (r & 3) + 8 * (r >> 2) + 4 * hi, k1 = k0 + 32;
        if (MODE == 1) { if (16 * k0 + 31 > tq) S0[r] = NINF; if (16 * k1 + 31 > tq) S1[r] = NINF; }
        if (MODE == 2) { if (k0 > tq) S0[r] = NINF; if (k1 > tq) S1[r] = NINF; }
        if (MODE == 3) { if ((unsigned)(tq - k0) >= 512u) S0[r] = NINF; if ((unsigned)(tq - k1) >= 512u) S1[r] = NINF; } }
}
constexpr float DEFER_THR = 8.0f;
template <int MODE> __device__ __forceinline__ void attn_tile(f32x16 (&O)[4], float& m, float& l, const bf16x8 (&qf)[8], LAS const unsigned char* kb, LAS const unsigned char* vb,
                                                                           int lane, int kbase, int tq, bool selbit, bool masked) {
    const float NINF = -__builtin_inff();
    f32x16 S0, S1;
    qk_tile(S0, S1, qf, kb, lane);
    if (MODE != 0 && masked) mask_raw<MODE>(S0, S1, kbase, tq, lane >> 5);
    float mt = NINF;
#pragma unroll
    for (int r = 0; r < 16; ++r) mt = fmaxf(mt, fmaxf(S0[r], S1[r]));
    mt = fmaxf(mt, __shfl_xor(mt, 32)) * SL2;
    if (MODE == 2) mt = selbit ? mt : NINF;
    const bool need = mt > m + DEFER_THR;
    if (__builtin_amdgcn_ballot_w64(need) != 0ull) {
        const float mn = need ? mt : m; const float alpha = __builtin_amdgcn_exp2f(m - mn); m = mn; l *= alpha;
#pragma unroll
        for (int db = 0; db < 4; ++db) O[db] = O[db] * alpha;
    }
    float nb = -m; if (MODE == 2) nb = selbit ? nb : NINF;
    float ls = 0.f;
#pragma unroll
    for (int r = 0; r < 16; ++r) { S0[r] = __builtin_amdgcn_exp2f(__builtin_fmaf(S0[r], SL2, nb)); S1[r] = __builtin_amdgcn_exp2f(__builtin_fmaf(S1[r], SL2, nb)); ls += S0[r] + S1[r]; }
    l += ls;
    const int vrow = lane & 31, vhi = lane >> 5, vx = (vrow >> 1) & 7;
    LAS const unsigned char* vp = vb + vrow * 128;
#define PV_STEP(st4, pfexpr) { const bf16x8 pf = pfexpr; const int voff = ((2 * (st4) + vhi) ^ vx) * 16; _Pragma("unroll") for (int db = 0; db < 4; ++db) { const bf16x8 vf = *(LAS const bf16x8*)(vp + db * 32 * 128 + voff); O[db] = MFMA32(vf, pf, O[db]); } }
    PV_STEP(0, pack_step<0>(S0)) PV_STEP(1, pack_step<1>(S0)) PV_STEP(2, pack_step<0>(S1)) PV_STEP(3, pack_step<1>(S1))
#undef PV_STEP
}
template <int MODE> __device__ __forceinline__ void attn_branch(f32x16 (&O)[4], float& m, float& l, const bf16x8 (&qf)[8], LAS unsigned char* lds, const bf16* Kb, int kpitch, const bf16* Vtb, int vts,
                                                                int jlo, int jhi, int tq, unsigned selmask, int tid, int lane, int w) {
    dma_k(lds + A_KB0, Kb + (size_t)jlo * 64 * kpitch, kpitch, tid, w); dma_v(lds + A_VB0, Vtb + jlo * 64, vts, tid, w);
    asm volatile("s_waitcnt vmcnt(0)" ::: "memory");
    __syncthreads();
    int buf = 0;
    for (int j = jlo; j <= jhi; ++j) {
        if (j < jhi) { dma_k(lds + (buf ? A_KB0 : A_KB1), Kb + (size_t)(j + 1) * 64 * kpitch, kpitch, tid, w); dma_v(lds + (buf ? A_VB0 : A_VB1), Vtb + (j + 1) * 64, vts, tid, w); }
        const bool masked = (MODE == 1) || (MODE == 2 && j == jhi) || (MODE == 3 && (j == jlo || j == jhi));
        attn_tile<MODE>(O, m, l, qf, lds + (buf ? A_KB1 : A_KB0), lds + (buf ? A_VB1 : A_VB0), lane, j * 64, tq, ((selmask >> j) & 1u) != 0u, masked);
        asm volatile("s_waitcnt vmcnt(0)" ::: "memory");
        __syncthreads();
        buf ^= 1;
    }
}
__device__ __forceinline__ void load_q(bf16x8 (&qf)[8], const bf16* qp  ) {
#pragma unroll
    for (int st = 0; st < 8; ++st) qf[st] = *(const bf16x8*)(qp + st * 16);
}
__device__ __forceinline__ float branch_inv(float l) { const float lt = l + __shfl_xor(l, 32); return lt > 0.f ? 1.0f / lt : 0.f; }

__device__ __forceinline__ void nsa_unit(const Ctx& C, int b, int g, int qb, LAS unsigned char* lds) {
    const int tid = tid_now(), lane = tid & 63, w = __builtin_amdgcn_readfirstlane(tid >> 6), hh = w >> 1, th = w & 1, c = lane & 31, hi = lane >> 5;
    const int tq = 64 * qb + 32 * th + c, head = g * 4 + hh; const size_t row = (size_t)b * SEQ + tq;
    const bf16* prow = C.P() + row * NP;
    bf16x8 qf[8];
    load_q(qf, prow + C_NQ + head * 128 + hi * 8);
    const float* ngp = C.ng() + row * 48 + head * 3; const float g0 = ngp[0], g1 = ngp[1], g2 = ngp[2];
    const size_t bg = (size_t)(b * 4 + g);
    f32x16 O[4]; float m, l;
    unsigned* tsc = C.tsc() + ((size_t)(blockIdx.x * NWAVES + w) * 32) * 64 + lane;
#pragma unroll
    for (int db = 0; db < 4; ++db)
#pragma unroll
        for (int r = 0; r < 16; ++r) O[db][r] = 0.f;
    m = -1e30f; l = 0.f;
    const bf16* Kc = C.Kc() + bg * 128 * 128; const bf16* Vtc = C.Vtc() + bg * 128 * 128;
    attn_branch<1>(O, m, l, qf, lds, Kc, 128, Vtc, 128, 0, (qb >= 16) ? 1 : 0, tq, 0u, tid, lane, w);
    const float inv0 = branch_inv(l);
    { const float sc = g0 * inv0;
#pragma unroll
      for (int db = 0; db < 4; ++db)
#pragma unroll
          for (int r = 0; r < 8; ++r) tsc[(db * 8 + r) * 64] = cvt_pk_bf16(O[db][2 * r] * sc, O[db][2 * r + 1] * sc); }
    unsigned selmask = 0xffffffffu;
    if (qb >= 16) {
        dma_k(lds + A_KB0, Kc, 128, tid, w); dma_k(lds + A_KB1, Kc + 64 * 128, 128, tid, w);
        asm volatile("s_waitcnt vmcnt(0)" ::: "memory");
        __syncthreads();
        float Gv[16], Ev[16];
#pragma unroll
        for (int t = 0; t < 2; ++t) {
            f32x16 S0, S1;
            qk_tile(S0, S1, qf, lds + (t ? A_KB1 : A_KB0), lane);
            mask_raw<1>(S0, S1, 64 * t, tq, hi);
#pragma unroll
            for (int r = 0; r < 16; ++r) { S0[r] = __builtin_amdgcn_exp2f(__builtin_fmaf(S0[r], SL2, -m)) * inv0; S1[r] = __builtin_amdgcn_exp2f(__builtin_fmaf(S1[r], SL2, -m)) * inv0; }
#pragma unroll
            for (int q4 = 0; q4 < 4; ++q4) {
                Gv[8 * t + q4] = (S0[4 * q4] + S0[4 * q4 + 1]) + (S0[4 * q4 + 2] + S0[4 * q4 + 3]); Ev[8 * t + q4] = S0[4 * q4 + 3];
                Gv[8 * t + 4 + q4] = (S1[4 * q4] + S1[4 * q4 + 1]) + (S1[4 * q4 + 2] + S1[4 * q4 + 3]); Ev[8 * t + 4 + q4] = S1[4 * q4 + 3]; }
        }
        float rv[16];
#pragma unroll
        for (int i = 0; i < 16; ++i) rv[i] = __shfl_xor(Ev[i], 32);
        LAS float* impw = (LAS float*)(lds + A_IMPW) + (w * 32 + c) * 33;
#pragma unroll
        for (int i = 0; i < 16; ++i) { const float add = hi ? rv[i] : (i > 0 ? rv[i > 0 ? i - 1 : 0] : 0.f); impw[2 * i + hi] = Gv[i] + add; }
        __syncthreads();
        {
            const int tk = tid >> 3, part = tid & 7, tth = tk >> 5, cc = tk & 31; LAS const float* iw = (LAS const float*)(lds + A_IMPW); LAS float* is = (LAS float*)(lds + A_IMPS);
#pragma unroll
            for (int jj = 0; jj < 4; ++jj) { const int j = 4 * part + jj; float s = 0.f;
#pragma unroll
                for (int h4 = 0; h4 < 4; ++h4) s += iw[((2 * h4 + tth) * 32 + cc) * 33 + j];
                is[tk * 33 + j] = s; }
        }
        __syncthreads();
        {
            const int tk = tid >> 3, part = tid & 7; LAS const float* is = (LAS const float*)(lds + A_IMPS) + tk * 33; const float PINF = __builtin_inff();
            unsigned bits = 0u;
#pragma unroll
            for (int jj = 0; jj < 4; ++jj) { const int j = 4 * part + jj;
                const float vj = (j > qb) ? -PINF : ((j == 0 || j == qb || j == qb - 1) ? PINF : is[j]); int cnt = 0;
                for (int k = 0; k < 32; ++k) { const float vk = (k > qb) ? -PINF : ((k == 0 || k == qb || k == qb - 1) ? PINF : is[k]); cnt += (vk > vj || (vk == vj && k < j)) ? 1 : 0; }
                if (cnt < 16) bits |= 1u << j; }
            bits |= __shfl_xor(bits, 1); bits |= __shfl_xor(bits, 2); bits |= __shfl_xor(bits, 4);
            if (part == 0) ((LAS unsigned*)(lds + A_SELM))[tk] = bits;
        }
        __syncthreads();
        selmask = ((LAS const unsigned*)(lds + A_SELM))[32 * th + c];
    }
    { const float* cs = C.cost() + (size_t)tq * 64 + hi * 8; const float* sn = C.sint() + (size_t)tq * 64 + hi * 8;
#pragma unroll
      for (int st = 0; st < 4; ++st) {
          const f32x4 c0 = *(const f32x4*)(cs + st * 16), c1 = *(const f32x4*)(cs + st * 16 + 4), s0 = *(const f32x4*)(sn + st * 16), s1 = *(const f32x4*)(sn + st * 16 + 4);
          const u32x4 a = __builtin_bit_cast(u32x4, qf[st]), bq = __builtin_bit_cast(u32x4, qf[st + 4]); u32x4 oa, ob;
#pragma unroll
          for (int e2 = 0; e2 < 4; ++e2) { const float x1l = bflo(a[e2]), x1h = bfhi(a[e2]), x2l = bflo(bq[e2]), x2h = bfhi(bq[e2]);
              const float cl = (e2 < 2) ? c0[2 * e2] : c1[2 * e2 - 4], ch = (e2 < 2) ? c0[2 * e2 + 1] : c1[2 * e2 - 3], sl = (e2 < 2) ? s0[2 * e2] : s1[2 * e2 - 4], sh = (e2 < 2) ? s0[2 * e2 + 1] : s1[2 * e2 - 3];
              oa[e2] = cvt_pk_bf16(x1l * cl - x2l * sl, x1h * ch - x2h * sh); ob[e2] = cvt_pk_bf16(x2l * cl + x1l * sl, x2h * ch + x1h * sh); }
          qf[st] = __builtin_bit_cast(bf16x8, oa); qf[st + 4] = __builtin_bit_cast(bf16x8, ob); } }
#pragma unroll
    for (int db = 0; db < 4; ++db)
#pragma unroll
        for (int r = 0; r < 16; ++r) O[db][r] = 0.f;
    m = -1e30f; l = 0.f;
    attn_branch<2>(O, m, l, qf, lds, C.Kr() + bg * SEQ * 128, 128, C.Vt() + bg * 128 * SEQ, SEQ, 0, qb, tq, selmask, tid, lane, w);
    { const float sc = g1 * branch_inv(l);
#pragma unroll
      for (int db = 0; db < 4; ++db)
#pragma unroll
          for (int r = 0; r < 8; ++r) { const unsigned t = tsc[(db * 8 + r) * 64]; tsc[(db * 8 + r) * 64] = cvt_pk_bf16(bflo(t) + O[db][2 * r] * sc, bfhi(t) + O[db][2 * r + 1] * sc); } }
#pragma unroll
    for (int db = 0; db < 4; ++db)
#pragma unroll
        for (int r = 0; r < 16; ++r) O[db][r] = 0.f;
    m = -1e30f; l = 0.f;
    attn_branch<3>(O, m, l, qf, lds, C.Kr() + (16 + bg) * SEQ * 128, 128, C.Vt() + (16 + bg) * 128 * SEQ, SEQ, (qb > 8) ? qb - 8 : 0, qb, tq, 0u, tid, lane, w);
    { const float sc = g2 * branch_inv(l);
      const bf16* zp = prow + C_NZ + head * 128 + 4 * hi; bf16* op = C.Y() + row * YK + 2048 + head * 128 + 4 * hi;
#pragma unroll
      for (int db = 0; db < 4; ++db)
#pragma unroll
          for (int q4 = 0; q4 < 4; ++q4) { const u32x2 zz = *(const u32x2*)(zp + 32 * db + 8 * q4); const unsigned t0 = tsc[(db * 8 + 2 * q4) * 64], t1 = tsc[(db * 8 + 2 * q4 + 1) * 64];
              const float o0 = (bflo(t0) + O[db][4 * q4] * sc) * siluf_(bflo(zz.x)), o1 = (bfhi(t0) + O[db][4 * q4 + 1] * sc) * siluf_(bfhi(zz.x));
              const float o2 = (bflo(t1) + O[db][4 * q4 + 2] * sc) * siluf_(bflo(zz.y)), o3 = (bfhi(t1) + O[db][4 * q4 + 3] * sc) * siluf_(bfhi(zz.y));
              u32x2 ov; ov.x = cvt_pk_bf16(o0, o1); ov.y = cvt_pk_bf16(o2, o3); *(u32x2*)(op + 32 * db + 8 * q4) = ov; } }
}

__device__ __forceinline__ void mem_unit(const Ctx& C, int l_, int b, int h, int tb, LAS unsigned char* lds) {
    const int tid = tid_now(), lane = tid & 63, w = __builtin_amdgcn_readfirstlane(tid >> 6), c = lane & 31, hi = lane >> 5;
    const int tq = 256 * tb + 32 * w + c; const size_t row = (size_t)b * SEQ + tq; const bf16* prow = C.P() + row * NP;
    bf16x8 qf[8];
    load_q(qf, prow + C_XQ + h * 128 + hi * 8);
    f32x16 O[4]; float m = -1e30f, l = 0.f;
#pragma unroll
    for (int db = 0; db < 4; ++db)
#pragma unroll
        for (int r = 0; r < 16; ++r) O[db][r] = 0.f;
    const size_t hb = (size_t)((l_ * 4 + b) * 4 + h);
    attn_branch<0>(O, m, l, qf, lds, C.memK() + hb * 256 * 128, 128, C.memVt() + hb * 128 * 256, 256, 0, 3, tq, 0u, tid, lane, w);
    const float sc = branch_inv(l);
    const bf16* zp = prow + C_XZ + h * 128 + 4 * hi; bf16* op = C.Y() + row * YK + 4096 + h * 128 + 4 * hi;
#pragma unroll
    for (int db = 0; db < 4; ++db)
#pragma unroll
        for (int q4 = 0; q4 < 4; ++q4) { const u32x2 zz = *(const u32x2*)(zp + 32 * db + 8 * q4);
            u32x2 ov; ov.x = cvt_pk_bf16(O[db][4 * q4] * sc * siluf_(bflo(zz.x)), O[db][4 * q4 + 1] * sc * siluf_(bfhi(zz.x)));
            ov.y = cvt_pk_bf16(O[db][4 * q4 + 2] * sc * siluf_(bflo(zz.y)), O[db][4 * q4 + 3] * sc * siluf_(bfhi(zz.y))); *(u32x2*)(op + 32 * db + 8 * q4) = ov; }
}

__device__ __forceinline__ void cmp_item(const Ctx& C, int l_, int item, LAS unsigned char* lds) {
    const int tid = tid_now(), lane = tid & 63, w = __builtin_amdgcn_readfirstlane(tid >> 6), r16 = lane & 15, quad = lane >> 4;
    const int nb = item & 7, c = (item >> 3) & 1, g = (item >> 4) & 3, b = item >> 6, n0 = 16 * nb;
    int n = n0 + r16; if (n > 126) n = 126;
    f32x4 acc[8];
#pragma unroll
    for (int cb = 0; cb < 8; ++cb) acc[cb] = (f32x4){0.f, 0.f, 0.f, 0.f};
    const bf16* W1 = C.W1_t() + (size_t)(l_ * 2 + c) * 128 * 4096;
    const bf16* abase = C.P() + ((size_t)b * SEQ + 16 * n) * NP + C_KV + (c * 4 + g) * 128 + quad * 8;
    bf16x8 av[4][4];
#pragma unroll
    for (int ll = 0; ll < 4; ++ll)
#pragma unroll
        for (int ks = 0; ks < 4; ++ks) av[ll][ks] = *(const bf16x8*)(abase + (size_t)(4 * w + ll) * NP + ks * 32);
#pragma unroll
    for (int ll = 0; ll < 4; ++ll) { const int lpos = 4 * w + ll; const bf16* bp = W1 + (size_t)r16 * 4096 + lpos * 128 + quad * 8;
#pragma unroll
        for (int ks = 0; ks < 4; ++ks) { bf16x8 bv[8];
#pragma unroll
            for (int cb = 0; cb < 8; ++cb) bv[cb] = *(const bf16x8*)(bp + (size_t)cb * 16 * 4096 + ks * 32);
#pragma unroll
            for (int cb = 0; cb < 8; ++cb) acc[cb] = MFMA16(av[ll][ks], bv[cb], acc[cb]); } }
    LAS float* red = (LAS float*)lds;
#pragma unroll
    for (int cb = 0; cb < 8; ++cb)
#pragma unroll
        for (int i = 0; i < 4; ++i) red[(w * 16 + 4 * quad + i) * 128 + 16 * cb + r16] = acc[cb][i];
    __syncthreads();
    LAS bf16* hid = (LAS bf16*)(lds + 65536);
#pragma unroll
    for (int q = 0; q < 4; ++q) { const int o = tid + 512 * q, rr = o >> 7, col = o & 127; float s = C.pb()[(l_ * 2 + c) * 128 + col];
#pragma unroll
        for (int ww = 0; ww < 8; ++ww) s += red[(ww * 16 + rr) * 128 + col];
        hid[rr * 136 + col] = f2bf(siluf_(s)); }
    __syncthreads();
    const bf16* W2 = C.W2_t() + (size_t)(l_ * 2 + c) * 128 * 128; f32x4 a2 = (f32x4){0.f, 0.f, 0.f, 0.f};
#pragma unroll
    for (int ks = 0; ks < 4; ++ks) { const bf16x8 a = *(LAS const bf16x8*)(hid + r16 * 136 + ks * 32 + quad * 8); const bf16x8 bb = *(const bf16x8*)(W2 + (size_t)(16 * w + r16) * 128 + ks * 32 + quad * 8); a2 = MFMA16(a, bb, a2); }
    const size_t bg = (size_t)(b * 4 + g); const int col = 16 * w + r16;
#pragma unroll
    for (int i = 0; i < 4; ++i) { const int nn = n0 + 4 * quad + i; const bf16 v = f2bf(nn < 127 ? a2[i] : 0.f);
        if (c == 0) C.Kc()[(bg * 128 + nn) * 128 + col] = v; else C.Vtc()[(bg * 128 + col) * 128 + ((nn & ~15) | perm16(nn & 15))] = v; }
    __syncthreads();
}
__device__ __forceinline__ void ropevt_item(const Ctx& C, int item, LAS unsigned char* lds) {
    const int tid = tid_now(); const int j0 = (item & 7) * 4, g = (item >> 3) & 3, b = (item >> 5) & 3, brk = item >> 7, br = brk + 1;
    const size_t bg = (size_t)(brk * 16 + b * 4 + g);
    {
        const int s = tid >> 3, d0 = 8 * (tid & 7); u32x4 a[4], bq[4]; f32x4 c0[4], c1[4], s0[4], s1[4];
#pragma unroll
        for (int u = 0; u < 4; ++u) { const int tok = 64 * (j0 + u) + s; const bf16* src = C.P() + ((size_t)b * SEQ + tok) * NP + C_KV + ((br * 2 + 0) * 4 + g) * 128 + d0;
            a[u] = *(const u32x4*)src; bq[u] = *(const u32x4*)(src + 64);
            const float* cs = C.cost() + (size_t)tok * 64 + d0; const float* sn = C.sint() + (size_t)tok * 64 + d0;
            c0[u] = *(const f32x4*)cs; c1[u] = *(const f32x4*)(cs + 4); s0[u] = *(const f32x4*)sn; s1[u] = *(const f32x4*)(sn + 4); }
#pragma unroll
        for (int u = 0; u < 4; ++u) { const int tok = 64 * (j0 + u) + s; u32x4 oa, ob;
#pragma unroll
            for (int e2 = 0; e2 < 4; ++e2) { const float x1l = bflo(a[u][e2]), x1h = bfhi(a[u][e2]), x2l = bflo(bq[u][e2]), x2h = bfhi(bq[u][e2]);
                const float cl = (e2 < 2) ? c0[u][2 * e2] : c1[u][2 * e2 - 4], ch = (e2 < 2) ? c0[u][2 * e2 + 1] : c1[u][2 * e2 - 3], sl = (e2 < 2) ? s0[u][2 * e2] : s1[u][2 * e2 - 4], sh = (e2 < 2) ? s0[u][2 * e2 + 1] : s1[u][2 * e2 - 3];
                oa[e2] = cvt_pk_bf16(x1l * cl - x2l * sl, x1h * ch - x2h * sh); ob[e2] = cvt_pk_bf16(x2l * cl + x1l * sl, x2h * ch + x1h * sh); }
            bf16* dst = C.Kr() + (bg * SEQ + tok) * 128 + d0; *(u32x4*)dst = oa; *(u32x4*)(dst + 64) = ob; }
    }
    {
        LAS bf16* vt = (LAS bf16*)lds; u32x4 v[8];
#pragma unroll
        for (int q = 0; q < 8; ++q) { const int id = tid + 512 * (q & 1), s = id >> 4, ch = id & 15, u = q >> 1;
            v[q] = *(const u32x4*)(C.P() + ((size_t)b * SEQ + 64 * (j0 + u) + s) * NP + C_KV + ((br * 2 + 1) * 4 + g) * 128 + ch * 8); }
#pragma unroll
        for (int q = 0; q < 8; ++q) { const int id = tid + 512 * (q & 1), s = id >> 4, ch = id & 15, u = q >> 1;
            LAS unsigned* d = (LAS unsigned*)(vt + u * (64 * 130) + s * 130 + ch * 8); d[0] = v[q].x; d[1] = v[q].y; d[2] = v[q].z; d[3] = v[q].w; }
        __syncthreads();
#pragma unroll
        for (int q = 0; q < 8; ++q) { const int id = tid + 512 * (q & 1), d = id >> 3, pc = id & 7, u = q >> 1; unsigned short e[8];
#pragma unroll
            for (int k = 0; k < 8; ++k) { const int key = 16 * (pc >> 1) + 8 * (k >> 2) + 4 * (pc & 1) + (k & 3); e[k] = vt[u * (64 * 130) + key * 130 + d]; }
            u32x4 o; o.x = e[0] | ((unsigned)e[1] << 16); o.y = e[2] | ((unsigned)e[3] << 16); o.z = e[4] | ((unsigned)e[5] << 16); o.w = e[6] | ((unsigned)e[7] << 16);
            *(u32x4*)(C.Vt() + (bg * 128 + d) * SEQ + 64 * (j0 + u) + 8 * pc) = o; }
        __syncthreads();
    }
}
__device__ __forceinline__ void gate_item(const Ctx& C, int l_, int item, LAS unsigned char* lds) {
    const int tid = tid_now(), lane = tid & 63, w = __builtin_amdgcn_readfirstlane(tid >> 6), r16 = lane & 15, quad = lane >> 4;
    const bf16* ap = C.xb() + (size_t)(32 * item + r16) * DM + w * 512 + quad * 8;
    const bf16* bp = C.Wg_t() + (size_t)l_ * 64 * DM + (size_t)r16 * DM + w * 512 + quad * 8;
    f32x4 acc[2][3];
#pragma unroll
    for (int rb = 0; rb < 2; ++rb)
#pragma unroll
        for (int cb = 0; cb < 3; ++cb) acc[rb][cb] = (f32x4){0.f, 0.f, 0.f, 0.f};
#pragma unroll
    for (int k0 = 0; k0 < 16; k0 += 8) { bf16x8 ag[2][8];
#pragma unroll
        for (int ks = 0; ks < 8; ++ks) { ag[0][ks] = *(const bf16x8*)(ap + (k0 + ks) * 32); ag[1][ks] = *(const bf16x8*)(ap + (size_t)16 * DM + (k0 + ks) * 32); }
#pragma unroll
        for (int ks = 0; ks < 8; ++ks) {
#pragma unroll
            for (int cb = 0; cb < 3; ++cb) { const bf16x8 bb = *(const bf16x8*)(bp + (size_t)cb * 16 * DM + (k0 + ks) * 32); acc[0][cb] = MFMA16(ag[0][ks], bb, acc[0][cb]); acc[1][cb] = MFMA16(ag[1][ks], bb, acc[1][cb]); } } }
    LAS float* red = (LAS float*)lds;
#pragma unroll
    for (int rb = 0; rb < 2; ++rb)
#pragma unroll
        for (int cb = 0; cb < 3; ++cb)
#pragma unroll
            for (int i = 0; i < 4; ++i) red[(w * 32 + 16 * rb + 4 * quad + i) * 48 + 16 * cb + r16] = acc[rb][cb][i];
    __syncthreads();
    for (int o = tid; o < 32 * 48; o += 512) { const int rr = o / 48, col = o - rr * 48; float s = 0.f;
#pragma unroll
        for (int q = 0; q < 8; ++q) s += red[(q * 32 + rr) * 48 + col];
        const int row = 32 * item + rr; C.ng()[(size_t)row * 48 + col] = sigmoidf_(s * C.rstd()[row]); }
    __syncthreads();
}
__device__ __forceinline__ void memvt_item(const Ctx& C, int item, LAS unsigned char* lds) {
    const int tid = tid_now(); const int t = item & 3, h = (item >> 2) & 3, b = (item >> 4) & 3, l_ = item >> 6;
    LAS bf16* vt = (LAS bf16*)lds;
#pragma unroll
    for (int q = 0; q < 2; ++q) { const int id = tid + 512 * q, s = id >> 4, ch = id & 15;
        *(u32x4*)(C.memK() + ((size_t)((l_ * 4 + b) * 4 + h) * 256 + 64 * t + s) * 128 + ch * 8) = *(const u32x4*)(C.MKV() + ((size_t)b * 256 + 64 * t + s) * 4096 + l_ * 1024 + h * 128 + ch * 8);
        const u32x4 v = *(const u32x4*)(C.MKV() + ((size_t)b * 256 + 64 * t + s) * 4096 + l_ * 1024 + 512 + h * 128 + ch * 8);
        LAS unsigned* d = (LAS unsigned*)(vt + s * 130 + ch * 8); d[0] = v.x; d[1] = v.y; d[2] = v.z; d[3] = v.w; }
    __syncthreads();
    const size_t hb = (size_t)((l_ * 4 + b) * 4 + h);
#pragma unroll
    for (int q = 0; q < 2; ++q) { const int id = tid + 512 * q, d = id >> 3, pc = id & 7; unsigned short e[8];
#pragma unroll
        for (int k = 0; k < 8; ++k) { const int key = 16 * (pc >> 1) + 8 * (k >> 2) + 4 * (pc & 1) + (k & 3); e[k] = vt[key * 130 + d]; }
        u32x4 o; o.x = e[0] | ((unsigned)e[1] << 16); o.y = e[2] | ((unsigned)e[3] << 16); o.z = e[4] | ((unsigned)e[5] << 16); o.w = e[6] | ((unsigned)e[7] << 16);
        *(u32x4*)(C.memVt() + (hb * 128 + d) * 256 + 64 * t + 8 * pc) = o; }
    __syncthreads();
}
__device__ __forceinline__ void conv_item(const Ctx& C, int l_, int item) {
    const int tid = tid_now(); const int ch = (tid & 255) * 8, t0 = 64 * item + 32 * (tid >> 8), sp0 = t0 & (SEQ - 1);
    const float* cw = C.conv_w + (size_t)l_ * 3 * 2048 + ch; const float* cbv = C.conv_b + (size_t)l_ * 2048 + ch;
    float w[3][8], bias[8], u1[8], u2[8];
#pragma unroll
    for (int k = 0; k < 3; ++k) { const f32x4 a = *(const f32x4*)(cw + k * 2048), c = *(const f32x4*)(cw + k * 2048 + 4); w[k][0] = a[0]; w[k][1] = a[1]; w[k][2] = a[2]; w[k][3] = a[3]; w[k][4] = c[0]; w[k][5] = c[1]; w[k][6] = c[2]; w[k][7] = c[3]; }
    { const f32x4 a = *(const f32x4*)cbv, c = *(const f32x4*)(cbv + 4); bias[0] = a[0]; bias[1] = a[1]; bias[2] = a[2]; bias[3] = a[3]; bias[4] = c[0]; bias[5] = c[1]; bias[6] = c[2]; bias[7] = c[3]; }
    const bf16* p = C.P() + (size_t)t0 * NP + ch;
#pragma unroll
    for (int e = 0; e < 8; ++e) { u1[e] = 0.f; u2[e] = 0.f; }
    if (sp0 >= 1) { const u32x4 hv = *(const u32x4*)(p - NP + C_AH), cv = *(const u32x4*)(p - NP + C_AC);
#pragma unroll
        for (int e2 = 0; e2 < 4; ++e2) { u1[2 * e2] = bflo(hv[e2]) * bflo(cv[e2]); u1[2 * e2 + 1] = bfhi(hv[e2]) * bfhi(cv[e2]); } }
    if (sp0 >= 2) { const u32x4 hv = *(const u32x4*)(p - 2 * (size_t)NP + C_AH), cv = *(const u32x4*)(p - 2 * (size_t)NP + C_AC);
#pragma unroll
        for (int e2 = 0; e2 < 4; ++e2) { u2[2 * e2] = bflo(hv[e2]) * bflo(cv[e2]); u2[2 * e2 + 1] = bfhi(hv[e2]) * bfhi(cv[e2]); } }
    bf16* yo = C.Y() + (size_t)t0 * YK + ch;
#pragma unroll 8
    for (int s = 0; s < 32; ++s) { const bf16* ps = p + (size_t)s * NP;
        const u32x4 hv = *(const u32x4*)(ps + C_AH), cv = *(const u32x4*)(ps + C_AC), bv = *(const u32x4*)(ps + C_AB), zv = *(const u32x4*)(ps + C_AZ); u32x4 o;
#pragma unroll
        for (int e2 = 0; e2 < 4; ++e2) { const float ul = bflo(hv[e2]) * bflo(cv[e2]), uh = bfhi(hv[e2]) * bfhi(cv[e2]);
            float yl = bias[2 * e2], yh = bias[2 * e2 + 1];
            yl += w[0][2 * e2] * u2[2 * e2]; yh += w[0][2 * e2 + 1] * u2[2 * e2 + 1];
            yl += w[1][2 * e2] * u1[2 * e2]; yh += w[1][2 * e2 + 1] * u1[2 * e2 + 1];
            yl += w[2][2 * e2] * ul; yh += w[2][2 * e2 + 1] * uh;
            u2[2 * e2] = u1[2 * e2]; u2[2 * e2 + 1] = u1[2 * e2 + 1]; u1[2 * e2] = ul; u1[2 * e2 + 1] = uh;
            o[e2] = cvt_pk_bf16(bflo(bv[e2]) * yl * siluf_(bflo(zv[e2])), bfhi(bv[e2]) * yh * siluf_(bfhi(zv[e2]))); }
        *(u32x4*)(yo + (size_t)s * YK) = o; }
}


#define GAS __attribute__((address_space(1)))
typedef float f32x4g __attribute__((ext_vector_type(4)));
__device__ __noinline__ void rstd_table(const GAS float* sp0, GAS float* rg, LAS float* rt) {
    const int t = threadIdx.x, row = t >> 1, half = t & 1; const GAS float* sp = sp0 + (size_t)row * 64 + half * 32; float s = 0.f;
#pragma unroll
    for (int k = 0; k < 8; ++k) { const f32x4 v = *(const GAS f32x4*)(sp + 4 * k); s += (v[0] + v[1]) + (v[2] + v[3]); }
    const float so = __shfl_xor(s, 1); const float tot = half ? (so + s) : (s + so); const float rs = 1.0f / sqrtf(tot * (1.0f / 4096.0f) + 1e-6f);
    if (half == 0) { rt[row] = rs; rg[row] = rs; }
}
constexpr int N_PHASES = 2 + 5 * NLAY + 1;
struct Args { const float* in[16]; float* out; unsigned char* ws; int ph_lo, ph_hi, li, pad; };
__global__ void __launch_bounds__(NWAVES * 64, 2) fwd(Args args) {
    extern __shared__ __attribute__((aligned(16))) unsigned char lds_raw[];
    LAS unsigned char* lds = (LAS unsigned char*)lds_raw;
    volatile LAS unsigned* MISC = (volatile LAS unsigned*)(lds + MISC_OFF);
    const int tid = tid_now();
    Ctx C;
    C.x = args.in[0]; C.mem = args.in[1]; C.norm_g = args.in[2]; C.w_in = args.in[3]; C.conv_w = args.in[4]; C.conv_b = args.in[5]; C.cmp_pos = args.in[6]; C.cmp_w1 = args.in[7];
    C.cmp_w2 = args.in[8]; C.mem_norm_g = args.in[9]; C.w_mem_kv = args.in[10]; C.w_up_a = args.in[11]; C.w_up_b = args.in[12]; C.w_up_x = args.in[13]; C.w_out = args.in[14]; C.final_g = args.in[15];
    C.out = args.out;
    unsigned char* ws = args.ws; C.ws = ws;
    C.G = gridDim.x; { const int bx = blockIdx.x; C.vcu = (C.G % 8 == 0) ? (bx % 8) * (C.G / 8) + bx / 8 : bx; }
    for (int u = tid; u < (LDS_BYTES - RING_BYTES) / 4; u += NWAVES * 64) ((LAS unsigned*)(lds + RING_BYTES))[u] = 0u;
    __syncthreads();
    const int lo = args.ph_lo, hi = args.ph_hi;
    const bool use_bar = (hi - lo) > 1;
    XcdBarrier bar; bar.bar = (unsigned*)(ws) + CW_BAR + args.li * XCD_BAR_WORDS; bar.x = 0; bar.st = MISC + 8;
    if (use_bar) bar = xcd_barrier_post((unsigned*)(ws) + CW_BAR + args.li * XCD_BAR_WORDS, MISC + 8);
#ifndef PHMASK
#define PHMASK 0xff
#endif
#define IN(k) (lo <= (k) && (k) < hi)
#define RELAUNDER() do { size_t z_ = 0; asm volatile("" : "+s"(z_)); C.ws = ws + z_; } while (0)
#define EN(b) ((PHMASK >> (b)) & 1)
#if defined(DOUBLE_BAR)
#define SEAM(k) do { if (IN(k) && IN((k) + 1)) { xcd_barrier(bar); xcd_barrier(bar); } } while (0)
#else
#define SEAM(k) do { if (IN(k) && IN((k) + 1)) xcd_barrier(bar); } while (0)
#endif

    if (EN(0) && IN(0)) { RELAUNDER(); p0_prologue(C, lds); __syncthreads(); }
    SEAM(0);
    if (EN(1) && IN(1)) { RELAUNDER();
        pg8::Gemm g{C.memb(), C.Wmkv_t(), NBAT * 256, 4096, DM}; pg8::StaticOrder S; S.init(NBAT * 256, 4096, C.G, bx_now());
        pg8::EpiProj E{C.MKV(), 4096, C.rstdm(), nullptr, nullptr, 0, 1 << 30};
        pg8::gemm_phase<pg8::EpiProj, pg8::StaticOrder, true, true>(lds, g, S, E);
        p0_tables(C);
        p0_convert(C, lds, (unsigned*)(ws) + CW_Q + 64 * args.li);
    }
    SEAM(1);
    for (int l = 0; l < NLAY; ++l) {
        const int pA = 2 + 5 * l;
        if (EN(2) && IN(pA)) { RELAUNDER();
            if (l == 0) { for (int it = blockIdx.x; it < 256; it += C.G) memvt_item(C, it, lds); }
            pg8::Gemm g{C.xb(), C.Win_t() + (size_t)l * NP * DM, TOK, NP, DM}; pg8::StaticOrder S; S.init(TOK, NP, C.G, bx_now()); S.mix = 1;
            PG8_LAS float* rt = (PG8_LAS float*)(lds + RT_OFF); int pm0 = -1; { pg8::Unit u0; if (S.next(0, u0)) pm0 = u0.pm; }
            if (pm0 >= 0) rstd_table((const GAS float*)(C.ssqp() + (size_t)pm0 * 256 * 64), (GAS float*)(C.rstd() + pm0 * 256), rt);
            __syncthreads();
            pg8::EpiProj E{C.P(), NP, nullptr, rt, C.G8(), 3 * DM, C_MG / 256};
            pg8::gemm_phase<pg8::EpiProj, pg8::StaticOrder, true, true>(lds, g, S, E);
        }
        SEAM(pA);
        if (EN(3) && IN(pA + 1)) { RELAUNDER();
            if (C.G == 256) {
                const int bxb = bx_now();
                if (bxb < 128) { mem_unit(C, l, bxb >> 5, (bxb >> 3) & 3, bxb & 7, lds); cmp_item(C, l, bxb, lds); ropevt_item(C, bxb, lds); ropevt_item(C, bxb + 128, lds); gate_item(C, l, bxb, lds); }
                else { conv_item(C, l, bxb - 128); cmp_item(C, l, bxb, lds); gate_item(C, l, bxb, lds); }
            } else
            for (int it = blockIdx.x; it < 128 + 128 + 256 + 256 + 256; it += C.G) {
                if (it < 128) { mem_unit(C, l, it >> 5, (it >> 3) & 3, it & 7, lds); }
                else if (it < 256) { conv_item(C, l, it - 128); }
                else if (it < 512) { cmp_item(C, l, it - 256, lds); }
                else if (it < 768) { ropevt_item(C, it - 512, lds); }
                else { gate_item(C, l, it - 768, lds); }
            }
        }
        SEAM(pA + 1);
        if (EN(4) && IN(pA + 2)) { RELAUNDER();
            for (int it = C.vcu; it < 256; it += C.G) { const int bg = it >> 4, pr = it & 15; nsa_unit(C, bg >> 2, bg & 3, 31 - pr, lds); nsa_unit(C, bg >> 2, bg & 3, pr, lds); }
        }
        SEAM(pA + 2);
        if (EN(5) && IN(pA + 3)) { RELAUNDER();
            pg8::Gemm g{C.Y(), C.Wup_t() + (size_t)l * DM * YK, TOK, DM, YK}; pg8::StaticOrder S; S.init(TOK, DM, C.G, bx_now());
            pg8::EpiUpF E{C.G8(), 3 * DM, DM, C.UB(), DM};
            pg8::gemm_phase<pg8::EpiUpF, pg8::StaticOrder, true, true>(lds, g, S, E);
        }
        SEAM(pA + 3);
        if (EN(6) && IN(pA + 4)) { RELAUNDER();
            pg8::Gemm g{C.UB(), C.Wo_t() + (size_t)l * DM * DM, TOK, DM, DM}; pg8::StaticOrder S; S.init(TOK, DM, C.G, bx_now());
            pg8::EpiOut E{C.xb(), C.ssqp(), DM};
            pg8::gemm_phase<pg8::EpiOut, pg8::StaticOrder, true, true>(lds, g, S, E);
        }
        SEAM(pA + 4);
    }
    if (EN(7) && IN(2 + 5 * NLAY)) { RELAUNDER(); final_phase(C); }
#undef IN
#undef EN
#undef SEAM
}


#ifndef N_LAUNCH_SPLIT
#define N_LAUNCH_SPLIT 0
#endif
extern "C" void kernel_launch(void* const* d_in, const int* in_sizes, int n_in, void* d_out, int out_size, void* d_ws, size_t ws_size, hipStream_t stream) {
    static int grid = 0;
    if (grid == 0) {
        if (n_in != 16 || out_size != TOK * DM || ws_size < WS_END) { fprintf(stderr, "kernel_launch: unexpected shapes (n_in %d, out %d, ws %zu < %zu)\n", n_in, out_size, ws_size, (size_t)WS_END); grid = -1; return; }
        int dev = 0, cus = 0;
        if (hipGetDevice(&dev) != hipSuccess || hipDeviceGetAttribute(&cus, hipDeviceAttributeMultiprocessorCount, dev) != hipSuccess) { grid = -1; return; }
        if (hipFuncSetAttribute((const void*)fwd, hipFuncAttributeMaxDynamicSharedMemorySize, LDS_BYTES) != hipSuccess) { fprintf(stderr, "kernel_launch: hipFuncSetAttribute failed\n"); grid = -1; return; }
        int per_cu = 0;
        if (hipOccupancyMaxActiveBlocksPerMultiprocessor(&per_cu, (const void*)fwd, NWAVES * 64, LDS_BYTES) != hipSuccess || per_cu < 1) fprintf(stderr, "kernel_launch: occupancy query says %d blocks per CU\n", per_cu);
        (void)hipGetLastError();
        grid = cus;
        { pg8::StaticOrder S; bool fixed = true;
          for (int c = 0; c < grid && fixed; ++c) { S.init(TOK, NP, grid, c); pg8::Unit u0, u; if (!S.next(0, u0)) continue; for (int i = 1; S.next(i, u); ++i) if (u.pm != u0.pm) { fixed = false; break; } }
          if (!fixed) { fprintf(stderr, "kernel_launch: unit order does not keep a workgroup inside one row panel at grid %d; nothing launched\n", grid); grid = -1; return; } }
    }
    if (grid < 0) return;
    (void)hipMemsetAsync(d_ws, 0, CTL_BYTES, stream);
    Args a{};
    for (int i = 0; i < 16; ++i) a.in[i] = (const float*)d_in[i];
    a.out = (float*)d_out; a.ws = (unsigned char*)d_ws;
#if N_LAUNCH_SPLIT
    for (int ph = 0; ph < N_PHASES; ++ph) { a.ph_lo = ph; a.ph_hi = ph + 1; hipLaunchKernelGGL(fwd, dim3(grid), dim3(NWAVES * 64), LDS_BYTES, stream, a);
    }
#elif defined(REPEAT_LO)
    a.ph_lo = 0; a.ph_hi = REPEAT_HI; a.li = 0; hipLaunchKernelGGL(fwd, dim3(grid), dim3(NWAVES * 64), LDS_BYTES, stream, a);
    a.ph_lo = REPEAT_LO; a.ph_hi = N_PHASES; a.li = 1; hipLaunchKernelGGL(fwd, dim3(grid), dim3(NWAVES * 64), LDS_BYTES, stream, a);
#elif defined(REPEAT_PH)
    a.ph_lo = 0; a.ph_hi = REPEAT_PH + 1; a.li = 0; hipLaunchKernelGGL(fwd, dim3(grid), dim3(NWAVES * 64), LDS_BYTES, stream, a);
    a.ph_lo = REPEAT_PH; a.ph_hi = N_PHASES; a.li = 1; hipLaunchKernelGGL(fwd, dim3(grid), dim3(NWAVES * 64), LDS_BYTES, stream, a);
#else
    a.ph_lo = 0; a.ph_hi = N_PHASES; hipLaunchKernelGGL(fwd, dim3(grid), dim3(NWAVES * 64), LDS_BYTES, stream, a);
#endif
}
```
